# Optimizing an MI355X kernel written in HIP

```python
import math
import jax, jax.numpy as jnp
from jax import lax
import numpy as np

D_MODEL = 1024
BATCH = 4
SEQ = 4096
DEPTH = 1

MEM_LEN = 256
EPS = 1e-6
M_HEADS = 4
M_INNER = 2 * D_MODEL
M_HD = M_INNER // M_HEADS
M_CONV = 4
M_CHUNK = 128
A_HEADS = 8
A_QK = D_MODEL // 16
A_V = 2 * A_QK
A_WIDTH = A_HEADS * A_V
Q_BLOCK = 128
X_HEADS = 4
X_HD = D_MODEL // X_HEADS
X_WIDTH = X_HEADS * X_HD
REL_BUCKETS = 32
REL_MAX_DIST = 128
D_FF = 2816
N_BRANCH = 3
IN_SIZES = [M_INNER, M_INNER, M_HEADS, M_HEADS,
            A_HEADS * 2 * A_QK, A_HEADS * 2 * A_QK, A_WIDTH,
            X_WIDTH, N_BRANCH * D_MODEL]
IN_WIDTH = sum(IN_SIZES)
IN_SPLITS = [int(s) for s in np.cumsum(IN_SIZES)[:-1]]

kernel_name = 'hybrid_mlstm_diffattn_xattn_block'


def rmsnorm(x, g):
    xf = x.astype(jnp.float32)
    y = xf * lax.rsqrt(jnp.mean(xf * xf, axis=-1, keepdims=True) + EPS)
    return (y * g.astype(jnp.float32)).astype(x.dtype)


def head_rmsnorm(h, g):
    B, H, S, d = h.shape
    hf = h.astype(jnp.float32)
    hn = hf * lax.rsqrt(jnp.mean(hf * hf, axis=-1, keepdims=True) + EPS)
    hn = jnp.transpose(hn, (0, 2, 1, 3)).reshape(B, S, H * d)
    return hn * g.astype(jnp.float32)


def swiglu(h, w_gu, w_down):
    gate, up = jnp.split(h @ w_gu, 2, axis=-1)
    return (jax.nn.silu(gate) * up) @ w_down


def causal_conv(x, w, b):
    C = x.shape[-1]
    y = lax.conv_general_dilated(x, w[:, None, :].astype(x.dtype), window_strides=(1,),
                                 padding=[(M_CONV - 1, 0)],
                                 dimension_numbers=('NWC', 'WIO', 'NWC'),
                                 feature_group_count=C)
    return y + b


def headwise(x, w):
    B, S, _ = x.shape
    H, d, _ = w.shape
    return jnp.einsum('bshd,hde->bhse', x.reshape(B, S, H, d), w)


def mlstm_chunkwise(q, k, v, ig, lf):
    B, H, S, d = q.shape
    L = M_CHUNK
    NC = S // L

    def chunks(a):
        return jnp.moveaxis(a.reshape((B, H, NC, L) + a.shape[3:]), 2, 0)

    causal = jnp.tril(jnp.ones((L, L), dtype=bool))

    def step(carry, inp):
        C, n, m = carry
        qb, kb, vb, ib, fb = inp
        b = jnp.cumsum(fb, axis=-1)
        dlog = b[..., :, None] - b[..., None, :] + ib[..., None, :]
        dlog = jnp.where(causal, dlog, -jnp.inf)
        inter = b + m[..., None]
        m_t = jnp.maximum(inter, jnp.max(dlog, axis=-1))
        w_intra = jnp.exp(dlog - m_t[..., None])
        w_inter = jnp.exp(inter - m_t)
        s = jnp.einsum('bhtd,bhsd->bhts', qb, kb) * w_intra
        num = jnp.einsum('bhts,bhse->bhte', s, vb) + w_inter[..., None] * jnp.einsum('bhtd,bhde->bhte', qb, C)
        den = jnp.sum(s, axis=-1) + w_inter * jnp.einsum('bhtd,bhd->bht', qb, n)
        h = num / jnp.maximum(jnp.abs(den), jnp.exp(-m_t))[..., None]
        bL = b[..., -1]
        tail = bL[..., None] - b + ib
        m_new = jnp.maximum(bL + m, jnp.max(tail, axis=-1))
        w_s = jnp.exp(tail - m_new[..., None])
        decay = jnp.exp(bL + m - m_new)
        C_new = decay[..., None, None] * C + jnp.einsum('bhs,bhsd,bhse->bhde', w_s, kb, vb)
        n_new = decay[..., None] * n + jnp.einsum('bhs,bhsd->bhd', w_s, kb)
        return (C_new, n_new, m_new), h

    init = (jnp.zeros((B, H, d, d), jnp.float32), jnp.zeros((B, H, d), jnp.float32),
            jnp.zeros((B, H), jnp.float32))
    _, hc = lax.scan(step, init, (chunks(q), chunks(k), chunks(v), chunks(ig), chunks(lf)))
    return jnp.moveaxis(hc, 0, 2).reshape(B, H, S, v.shape[-1])


def t5_bucket(rel):
    n = jnp.maximum(-rel, 0)
    max_exact = REL_BUCKETS // 2
    nf = jnp.maximum(n, 1).astype(jnp.float32)
    large = max_exact + (jnp.log(nf / max_exact) / math.log(REL_MAX_DIST / max_exact)
                         * (REL_BUCKETS - max_exact)).astype(jnp.int32)
    large = jnp.minimum(large, REL_BUCKETS - 1)
    return jnp.where(n < max_exact, n, large)


def diff_attention(q1, q2, k1, k2, v, positions, rel_bias, lam):
    B, H, S, dq = q1.shape
    NB = S // Q_BLOCK
    scale = dq ** -0.5

    def to_blocks(a):
        return jnp.moveaxis(a.reshape(B, H, NB, Q_BLOCK, a.shape[-1]), 2, 0)

    def block(inp):
        q1b, q2b, pq = inp
        rel = positions[None, :] - pq[:, None]
        bias = jnp.transpose(rel_bias[t5_bucket(rel)], (2, 0, 1))[None].astype(jnp.float32)
        visible = rel <= 0

        def probs(qb, kk):
            s = jnp.einsum('bhqd,bhkd->bhqk', qb, kk).astype(jnp.float32) * scale + bias
            return jax.nn.softmax(jnp.where(visible, s, -jnp.inf), axis=-1)

        a = probs(q1b, k1) - lam * probs(q2b, k2)
        return jnp.einsum('bhqk,bhkd->bhqd', a.astype(v.dtype), v)

    out = lax.map(block, (to_blocks(q1), to_blocks(q2), positions.reshape(NB, Q_BLOCK)))
    return jnp.moveaxis(out, 0, 2).reshape(B, H, S, v.shape[-1])


def cross_attention(qx, mem_n, w_mem_kv):
    B, S, _ = qx.shape
    kx, vx = jnp.split(mem_n @ w_mem_kv, 2, axis=-1)
    q = qx.reshape(B, S, X_HEADS, X_HD)
    k = kx.reshape(B, MEM_LEN, X_HEADS, X_HD)
    v = vx.reshape(B, MEM_LEN, X_HEADS, X_HD)
    s = jnp.einsum('bshd,bmhd->bhsm', q, k).astype(jnp.float32) * X_HD ** -0.5
    p = jax.nn.softmax(s, axis=-1).astype(v.dtype)
    return jnp.einsum('bhsm,bmhd->bshd', p, v).reshape(B, S, X_WIDTH)


def setup_inputs(seed: int = 0) -> dict:
    key = jax.random.key(seed)
    ks = iter(jax.random.split(key, 40))

    def nrm(shape, scale):
        return jax.random.normal(next(ks), shape, jnp.float32) * scale

    def gain(shape):
        return 1.0 + nrm(shape, 0.02)

    L, D = DEPTH, D_MODEL
    f_bias = jnp.broadcast_to(jnp.linspace(3.0, 6.0, M_HEADS, dtype=jnp.float32), (L, M_HEADS))
    b_if = jnp.concatenate([nrm((L, M_HEADS), 0.1), f_bias + nrm((L, M_HEADS), 0.1)], axis=-1)
    offset = jax.random.randint(next(ks), (), 0, 1024, dtype=jnp.int32)
    return {
        'x': nrm((BATCH, SEQ, D), 1.0),
        'mem': nrm((BATCH, MEM_LEN, D), 1.0),
        'positions': offset + jnp.arange(SEQ, dtype=jnp.int32),
        'rel_bias': nrm((REL_BUCKETS, A_HEADS), 0.5),
        'ffn1_norm': gain((L, D)),
        'ffn1_w_gu': nrm((L, D, 2 * D_FF), D ** -0.5),
        'ffn1_w_down': nrm((L, D_FF, D), D_FF ** -0.5),
        'mix_norm': gain((L, D)),
        'mem_norm': gain((L, D)),
        'w_in': nrm((L, D, IN_WIDTH), D ** -0.5),
        'b_if': b_if,
        'b_gate': nrm((L, N_BRANCH * D), 0.01),
        'm_conv_w': nrm((L, M_CONV, M_INNER), 0.5),
        'm_conv_b': nrm((L, M_INNER), 0.01),
        'm_wq': nrm((L, M_HEADS, M_HD, M_HD), M_HD ** -0.5),
        'm_wk': nrm((L, M_HEADS, M_HD, M_HD), M_HD ** -0.5),
        'm_wv': nrm((L, M_HEADS, M_HD, M_HD), M_HD ** -0.5),
        'm_head_norm': gain((L, M_INNER)),
        'a_lam_q1': nrm((L, A_QK), 0.1),
        'a_lam_k1': nrm((L, A_QK), 0.1),
        'a_lam_q2': nrm((L, A_QK), 0.1),
        'a_lam_k2': nrm((L, A_QK), 0.1),
        'a_head_norm': gain((L, A_WIDTH)),
        'w_mem_kv': nrm((L, D, 2 * X_WIDTH), D ** -0.5),
        'w_branch_m': nrm((L, M_INNER, D), M_INNER ** -0.5),
        'w_branch_a': nrm((L, A_WIDTH, D), A_WIDTH ** -0.5),
        'w_branch_x': nrm((L, X_WIDTH, D), X_WIDTH ** -0.5),
        'w_out': nrm((L, D, D), D ** -0.5),
        'ffn2_norm': gain((L, D)),
        'ffn2_w_gu': nrm((L, D, 2 * D_FF), D ** -0.5),
        'ffn2_w_down': nrm((L, D_FF, D), D_FF ** -0.5),
        'final_norm': gain((D,)),
    }


def reference(x, mem, positions, rel_bias, ffn1_norm, ffn1_w_gu, ffn1_w_down, mix_norm, mem_norm,
              w_in, b_if, b_gate, m_conv_w, m_conv_b, m_wq, m_wk, m_wv, m_head_norm,
              a_lam_q1, a_lam_k1, a_lam_q2, a_lam_k2, a_head_norm, w_mem_kv,
              w_branch_m, w_branch_a, w_branch_x, w_out, ffn2_norm, ffn2_w_gu, ffn2_w_down,
              final_norm):
    B, S, D = x.shape
    for l in range(DEPTH):
        x = x + 0.5 * swiglu(rmsnorm(x, ffn1_norm[l]), ffn1_w_gu[l], ffn1_w_down[l])

        h = rmsnorm(x, mix_norm[l])
        (xm, o_pre, i_pre, f_pre, qa, ka, va, qx, g_pre) = jnp.split(h @ w_in[l], IN_SPLITS, axis=-1)

        xc = jax.nn.silu(causal_conv(xm, m_conv_w[l], m_conv_b[l]))
        q_m = headwise(xc, m_wq[l]).astype(jnp.float32)
        k_m = headwise(xc, m_wk[l]).astype(jnp.float32) * M_HD ** -0.5
        v_m = headwise(xm, m_wv[l]).astype(jnp.float32)
        gates_if = (jnp.concatenate([i_pre, f_pre], axis=-1) + b_if[l]).astype(jnp.float32)
        ig = jnp.transpose(gates_if[..., :M_HEADS], (0, 2, 1))
        lf = jnp.transpose(jax.nn.log_sigmoid(gates_if[..., M_HEADS:]), (0, 2, 1))
        h_m = mlstm_chunkwise(q_m, k_m, v_m, ig, lf)
        y_m = (jax.nn.sigmoid(o_pre.astype(jnp.float32)) * head_rmsnorm(h_m, m_head_norm[l])).astype(x.dtype)

        qa = jnp.transpose(qa.reshape(B, S, A_HEADS, 2, A_QK), (3, 0, 2, 1, 4))
        ka = jnp.transpose(ka.reshape(B, S, A_HEADS, 2, A_QK), (3, 0, 2, 1, 4))
        va = jnp.transpose(va.reshape(B, S, A_HEADS, A_V), (0, 2, 1, 3))
        lam_init = 0.8 - 0.6 * math.exp(-0.3 * l)
        lam = (jnp.exp(jnp.sum(a_lam_q1[l] * a_lam_k1[l]).astype(jnp.float32))
               - jnp.exp(jnp.sum(a_lam_q2[l] * a_lam_k2[l]).astype(jnp.float32)) + lam_init)
        h_a = diff_attention(qa[0], qa[1], ka[0], ka[1], va, positions, rel_bias, lam)
        y_a = (head_rmsnorm(h_a, a_head_norm[l]) * (1.0 - lam_init)).astype(x.dtype)

        y_x = cross_attention(qx, rmsnorm(mem, mem_norm[l]), w_mem_kv[l])

        g = jax.nn.sigmoid(g_pre + b_gate[l]).reshape(B, S, N_BRANCH, D)
        merged = (g[:, :, 0] * (y_m @ w_branch_m[l]) + g[:, :, 1] * (y_a @ w_branch_a[l])
                  + g[:, :, 2] * (y_x @ w_branch_x[l]))
        x = x + merged @ w_out[l]

        x = x + 0.5 * swiglu(rmsnorm(x, ffn2_norm[l]), ffn2_w_gu[l], ffn2_w_down[l])
    return rmsnorm(x, final_norm)
```

```cpp
#include <hip/hip_runtime.h>
#include <cstdio>
#include <cstdint>

#define LAS __attribute__((address_space(3)))
typedef unsigned short bf16_t;
typedef short bf16x8 __attribute__((ext_vector_type(8)));
typedef short bf16x4 __attribute__((ext_vector_type(4)));
typedef float f32x2 __attribute__((ext_vector_type(2)));
typedef float f32x4 __attribute__((ext_vector_type(4)));
typedef float f32x16 __attribute__((ext_vector_type(16)));
typedef unsigned u32x2 __attribute__((ext_vector_type(2)));
typedef unsigned u32x4 __attribute__((ext_vector_type(4)));
typedef __bf16 bf2_t __attribute__((ext_vector_type(2)));

#ifndef REP_MASK
#define REP_MASK 0ull
#endif
#ifndef DRYMODE
#define DRYMODE 0
#endif
#ifndef DRY_EXTRA
#define DRY_EXTRA 0ull
#endif
#define DRY_MASK (DRY_EXTRA | (1ull << PH_O0) | (1ull << PH_O1) | (1ull << PH_BM1) | (1ull << PH_ATT) | (1ull << PH_BAX) | (1ull << PH_WOUT) | (1ull << PH_DN2) | (1ull << PH_FINAL))
#ifndef REP_N
#define REP_N 1
#endif
#ifndef N_LAUNCH_MODE
#define N_LAUNCH_MODE 1
#endif

constexpr int T = 16384, D = 1024, SEQ = 4096, NB = 4, DFF = 2816, MEML = 256;
constexpr float EPS = 1e-6f;
constexpr float LOG2E = 1.4426950408889634f;

constexpr size_t MiB = 1u << 20;
constexpr size_t WS_CTL = 0, CTL_BYTES = 64 * 1024;
constexpr size_t WS_GATES = 1 * MiB;
constexpr size_t WS_AS = WS_GATES + 512 * 1024;
constexpr size_t WS_MT = WS_AS + 256 * 1024;
constexpr size_t WS_WI = WS_MT + 256 * 1024;
constexpr size_t WS_LB = WS_WI + 256 * 1024;
constexpr size_t WS_WS = WS_LB + 256 * 1024;
constexpr size_t WS_SDEN = WS_WS + 256 * 1024;
constexpr size_t WS_DEN = WS_SDEN + 256 * 1024;
constexpr size_t WS_DEC = WS_DEN + 256 * 1024;
constexpr size_t WS_TAB = WS_DEC + 4096;
constexpr size_t WS_SSQ = 4 * MiB;
constexpr size_t WS_MEMN = 8 * MiB;
constexpr size_t WS_KX = 10 * MiB;
constexpr size_t WS_VXT = 12 * MiB;
constexpr size_t WS_DENP = 14 * MiB;
constexpr size_t WS_W = 16 * MiB;
constexpr size_t WS_WIN = WS_W;
constexpr size_t WS_AT = WS_WIN + 22 * MiB;
constexpr size_t WS_WVT = WS_AT + 2 * MiB;
constexpr size_t WS_WMKV = WS_WVT + 2 * MiB;
constexpr size_t WS_WBM = WS_WMKV + 4 * MiB;
constexpr size_t WS_WBA = WS_WBM + 4 * MiB;
constexpr size_t WS_WBX = WS_WBA + 2 * MiB;
constexpr size_t WS_WOUT = WS_WBX + 2 * MiB;
constexpr size_t WS_H = 56 * MiB;
constexpr size_t WS_MERGED = 88 * MiB;
constexpr size_t WS_A = 120 * MiB, WS_B = 152 * MiB, WS_C = 184 * MiB, WS_D = 216 * MiB;
constexpr size_t WS_S = 248 * MiB;
constexpr size_t WS_ACT = WS_A;
constexpr size_t WS_WGU = 208 * MiB;
constexpr size_t WS_WDN = 219 * MiB;
constexpr size_t WS_END = 256 * MiB;

constexpr int SCAN_PARTS = 32;
constexpr int LDS_BYTES = 153600;
constexpr int LDS_BAR = 153600 - 64;

__device__ __forceinline__ unsigned pk2(float lo, float hi) { f32x2 v = {lo, hi}; bf2_t b = __builtin_convertvector(v, bf2_t); return __builtin_bit_cast(unsigned, b); }
__device__ __forceinline__ float bflo(unsigned u) { return __uint_as_float(u << 16); }
__device__ __forceinline__ float bfhi(unsigned u) { return __uint_as_float(u & 0xffff0000u); }
template <int CTRL> __device__ __forceinline__ float dpp_mov(float v) { return __int_as_float(__builtin_amdgcn_update_dpp(0, __float_as_int(v), CTRL, 0xF, 0xF, true)); }
__device__ __forceinline__ float wave_sum(float v) {
    v += dpp_mov<0xB1>(v); v += dpp_mov<0x4E>(v); v += dpp_mov<0x141>(v); v += dpp_mov<0x140>(v);
    const int iv = __float_as_int(v);
    return (__int_as_float(__builtin_amdgcn_readlane(iv, 0)) + __int_as_float(__builtin_amdgcn_readlane(iv, 16))) + (__int_as_float(__builtin_amdgcn_readlane(iv, 32)) + __int_as_float(__builtin_amdgcn_readlane(iv, 48)));
}
template <int Dn> __device__ __forceinline__ float row_shr(float v, float fill) {
    return __int_as_float(__builtin_amdgcn_update_dpp(__float_as_int(fill), __float_as_int(v), 0x110 + Dn, 0xF, 0xF, false));
}
__device__ __forceinline__ float fast_rcp(float x) { return __builtin_amdgcn_rcpf(x); }
__device__ __forceinline__ float sigmoidf_(float x) { return fast_rcp(1.f + __expf(-x)); }

struct Params {
    const float *x, *mem; const int* positions;
    const float *rel_bias, *ffn1_norm, *ffn1_w_gu, *ffn1_w_down, *mix_norm, *mem_norm, *w_in, *b_if, *b_gate, *m_conv_w, *m_conv_b,
        *m_wq, *m_wk, *m_wv, *m_head_norm, *a_lam_q1, *a_lam_k1, *a_lam_q2, *a_lam_k2, *a_head_norm, *w_mem_kv, *w_branch_m, *w_branch_a,
        *w_branch_x, *w_out, *ffn2_norm, *ffn2_w_gu, *ffn2_w_down, *final_norm;
    float* out; unsigned char* ws;
    int ph_lo, ph_hi;
};

#define GAS __attribute__((address_space(1)))
struct ParamsG {
    GAS const float *x, *mem; GAS const int* positions;
    GAS const float *rel_bias, *ffn1_norm, *ffn1_w_gu, *ffn1_w_down, *mix_norm, *mem_norm, *w_in, *b_if, *b_gate, *m_conv_w, *m_conv_b,
        *m_wq, *m_wk, *m_wv, *m_head_norm, *a_lam_q1, *a_lam_k1, *a_lam_q2, *a_lam_k2, *a_head_norm, *w_mem_kv, *w_branch_m, *w_branch_a,
        *w_branch_x, *w_out, *ffn2_norm, *ffn2_w_gu, *ffn2_w_down, *final_norm;
    GAS float* out; GAS unsigned char* ws;
    int ph_lo, ph_hi;
};
static_assert(sizeof(ParamsG) == sizeof(Params), "ParamsG mirrors Params");
template <class T> __device__ __forceinline__ T* gp(GAS T* p) { return (T*)p; }
typedef const __attribute__((address_space(4))) ParamsG& PRef;

namespace pg8 {
constexpr int BM = 256, BK = 64, HALF = 128, HTB = HALF * BK * 2, STAGE_BYTES = 8 * HTB, NXCD = 8, WGM = 8;
__host__ __device__ __forceinline__ int lds_byte(int r, int c) { const int st = (r >> 4) * 2 + (c >> 5), rr = r & 15, cc = c & 31, ob = rr * 64 + cc * 2; return st * 1024 + (ob ^ (((ob >> 9) & 1) << 5)); }
__host__ __device__ __forceinline__ void stage_rc(int b, int& R, int& C) { const int st = b / 1024, sb = b % 1024, swz = sb ^ (((sb >> 9) & 1) << 5); R = (st >> 1) * 16 + swz / 64; C = (st & 1) * 32 + (swz % 64) / 2; }
__host__ __device__ __forceinline__ int perm32(int rho) { const int n = rho >> 4, i = rho & 15; return 8 * (i >> 2) + 4 * n + (i & 3); }

struct Unit { int pm, pn; };
enum EpiKind { E_NONE = 0, E_SWIGLU, E_RESID, E_BF16, E_SIGB, E_TRANS, E_OGATE, E_MERGE0, E_MERGE1, E_MERGE2, E_QPANEL };
struct Job {
    const bf16_t* A; const bf16_t* Bt; int lda, ldb, K, nM, nN, c;
    int kind;
    void* o0; const void* p1; const void* p2; const void* p3; const void* p4;
    int i0, i1, i2; long s0, s1; float f0; int dry;
};
typedef f32x4 Acc[2][2][4][2];
__device__ __forceinline__ bool next_unit(const Job& g, int G, int i, Unit& u) {
    const long L = (long)i * G + g.c; const int nwg = g.nM * g.nN;
    if (L >= (long)nwg) return false;
    int wgid = (int)L;
    { const int q = nwg / NXCD, r = nwg % NXCD, xcd = wgid % NXCD, off = wgid / NXCD; wgid = (xcd < r ? xcd * (q + 1) : r * (q + 1) + (xcd - r) * q) + off; }
    const int nig = WGM * g.nN, gid = wgid / nig, fm = gid * WGM, gsz = (g.nM - fm) < WGM ? (g.nM - fm) : WGM;
    u.pm = fm + ((wgid % nig) % gsz); u.pn = (wgid % nig) / gsz; return true;
}
__device__ __forceinline__ void unpack8(const u32x4 v, float (&o)[8]) { o[0] = bflo(v.x); o[1] = bfhi(v.x); o[2] = bflo(v.y); o[3] = bfhi(v.y); o[4] = bflo(v.z); o[5] = bfhi(v.z); o[6] = bflo(v.w); o[7] = bfhi(v.w); }
__device__ __forceinline__ u32x4 pack8(const float (&o)[8]) { u32x4 w; w.x = pk2(o[0], o[1]); w.y = pk2(o[2], o[3]); w.z = pk2(o[4], o[5]); w.w = pk2(o[6], o[7]); return w; }

template <bool SWAP>
__device__ __forceinline__ void epilogue(const Job& g, const Acc& acc, const Unit& u, int wr, int wc, int fr, int fq) {
    if (g.dry) return;
    if (SWAP) {
        bf16_t* O = (bf16_t*)g.o0; const int rb = g.i0, cg = g.i1, bs = g.i2; const int rbmask = (1 << rb) - 1, cgmask = (1 << cg) - 1, bmask = (1 << bs) - 1;
#pragma unroll
        for (int ai = 0; ai < 2; ++ai)
#pragma unroll
            for (int m = 0; m < 4; ++m) { const int r = u.pm * BM + ai * HALF + wr * 64 + m * 16 + 4 * fq;
#pragma unroll
                for (int bj = 0; bj < 2; ++bj)
#pragma unroll
                    for (int n = 0; n < 2; ++n) { const int c = u.pn * BM + bj * HALF + wc * 32 + perm32(16 * n + fr); const f32x4 v = acc[ai][bj][m][n];
                        u32x2 w; w.x = pk2(v[0], v[1]); w.y = pk2(v[2], v[3]);
                        *(u32x2*)(O + (size_t)(r >> rb) * g.s0 + (size_t)(c >> cg) * g.s1 + ((size_t)((r & rbmask) >> bs) << (cg + bs)) + ((size_t)(c & cgmask) << bs) + (r & bmask)) = w; } }
        return;
    }
    const int row0 = u.pm * BM + wr * 64 + fr;
    const int cw = wc * 32 + 8 * fq;
    switch (g.kind) {
    case E_SWIGLU: {
        bf16_t* O = (bf16_t*)g.o0;
#pragma unroll
        for (int ai = 0; ai < 2; ++ai)
#pragma unroll
            for (int m = 0; m < 4; ++m) { float v[8];
#pragma unroll
                for (int n = 0; n < 2; ++n)
#pragma unroll
                    for (int j = 0; j < 4; ++j) { const float gt = acc[ai][0][m][n][j], up = acc[ai][1][m][n][j]; v[n * 4 + j] = gt * sigmoidf_(gt) * up; }
                *(u32x4*)(O + (size_t)(row0 + ai * HALF + m * 16) * DFF + u.pn * HALF + cw) = pack8(v); }
    } break;
    case E_RESID: {
        const float* base = (const float*)g.p1; float* out = (float*)g.o0; const float alpha = g.f0;
#pragma unroll
        for (int ai = 0; ai < 2; ++ai)
#pragma unroll
            for (int m = 0; m < 4; ++m) { const size_t off = (size_t)(row0 + ai * HALF + m * 16) * D + u.pn * BM + cw;
#pragma unroll
                for (int bj = 0; bj < 2; ++bj)
#pragma unroll
                    for (int n = 0; n < 2; ++n) { const f32x4 bs = *(const f32x4*)(base + off + bj * HALF + n * 4); *(f32x4*)(out + off + bj * HALF + n * 4) = bs + alpha * acc[ai][bj][m][n]; } }
    } break;
    case E_BF16: case E_SIGB: {
        bf16_t* base = (bf16_t*)g.o0; const int ldc = g.i0; int pn = u.pn;
        if (g.i1) { const int t = pn / g.i1; base += (size_t)t * g.s0; pn -= t * g.i1; }
        const float* bias = (const float*)g.p1;
#pragma unroll
        for (int ai = 0; ai < 2; ++ai)
#pragma unroll
            for (int m = 0; m < 4; ++m) { bf16_t* rowp = base + (size_t)(row0 + ai * HALF + m * 16) * ldc + pn * BM + cw;
#pragma unroll
                for (int bj = 0; bj < 2; ++bj) { float v[8];
#pragma unroll
                    for (int j = 0; j < 4; ++j) { v[j] = acc[ai][bj][m][0][j]; v[4 + j] = acc[ai][bj][m][1][j]; }
                    if (g.kind == E_SIGB) { const f32x4 b0 = *(const f32x4*)(bias + u.pn * BM + cw + bj * HALF), b1 = *(const f32x4*)(bias + u.pn * BM + cw + bj * HALF + 4);
#pragma unroll
                        for (int j = 0; j < 4; ++j) { v[j] = sigmoidf_(v[j] + b0[j]); v[4 + j] = sigmoidf_(v[4 + j] + b1[j]); } }
                    *(u32x4*)(rowp + bj * HALF) = pack8(v); } }
    } break;
    case E_QPANEL: {
        bf16_t* O = (bf16_t*)g.o0;
#pragma unroll
        for (int ai = 0; ai < 2; ++ai)
#pragma unroll
            for (int m = 0; m < 4; ++m) { const int t = row0 + ai * HALF + m * 16;
#pragma unroll
                for (int bj = 0; bj < 2; ++bj) { float v[8];
#pragma unroll
                    for (int j = 0; j < 4; ++j) { v[j] = acc[ai][bj][m][0][j]; v[4 + j] = acc[ai][bj][m][1][j]; }
                    const int dg = (u.pn * BM + bj * HALF + cw) >> 3;
                    *(u32x4*)(O + (size_t)(t >> 12) * g.s0 + ((size_t)dg * SEQ + (t & 4095)) * 8) = pack8(v); } }
    } break;
    case E_OGATE: {
        bf16_t* NUM = (bf16_t*)g.o0; const float *SDENv = (const float*)g.p1, *LBv = (const float*)g.p2, *SSQ = (const float*)g.p3, *gnorm = (const float*)g.p4; const int pair = g.i0;
        const bf16_t* DENP = (const bf16_t*)((const unsigned char*)SSQ + (WS_DENP - WS_SSQ));
        const int hz = u.pn >> 1, hg = pair * 2 + hz;
#pragma unroll
        for (int ai = 0; ai < 2; ++ai)
#pragma unroll
            for (int m = 0; m < 4; ++m) { const int t = row0 + ai * HALF + m * 16;
                const f32x4* sp = (const f32x4*)(SSQ + ((size_t)t * 2 + hz) * 32); float ss = 0.f;
#pragma unroll
                for (int q = 0; q < SCAN_PARTS / 4; ++q) { const f32x4 s4 = sp[q]; ss += (s4[0] + s4[1]) + (s4[2] + s4[3]); }
                float den = SDENv[(size_t)t * 4 + hg]; const float lb = LBv[(size_t)t * 4 + hg];
                { const u32x4* dpp = (const u32x4*)(DENP + ((size_t)t * 2 + hz) * 32);
#pragma unroll
                  for (int q = 0; q < SCAN_PARTS / 8; ++q) { float dv[8]; unpack8(dpp[q], dv); den += ((dv[0] + dv[1]) + (dv[2] + dv[3])) + ((dv[4] + dv[5]) + (dv[6] + dv[7])); } }
                const float inv = 1.0f / fmaxf(fabsf(den), lb);
                const float sc = inv * (1.0f / sqrtf(inv * inv * ss * (1.0f / 512.f) + EPS));
                bf16_t* rowp = NUM + (size_t)t * D + u.pn * BM + cw;
#pragma unroll
                for (int bj = 0; bj < 2; ++bj) { float nv[8], o[8]; unpack8(*(const u32x4*)(rowp + bj * HALF), nv);
                    const f32x4 g0 = *(const f32x4*)(gnorm + pair * 1024 + u.pn * BM + cw + bj * HALF), g1 = *(const f32x4*)(gnorm + pair * 1024 + u.pn * BM + cw + bj * HALF + 4);
#pragma unroll
                    for (int j = 0; j < 4; ++j) { o[j] = sigmoidf_(acc[ai][bj][m][0][j]) * nv[j] * sc * g0[j]; o[4 + j] = sigmoidf_(acc[ai][bj][m][1][j]) * nv[4 + j] * sc * g1[j]; }
                    *(u32x4*)(rowp + bj * HALF) = pack8(o); } }
    } break;
    case E_MERGE0: case E_MERGE1: case E_MERGE2: {
        bf16_t* Mg = (bf16_t*)g.o0; const bf16_t* G = (const bf16_t*)g.p1;
#pragma unroll
        for (int ai = 0; ai < 2; ++ai)
#pragma unroll
            for (int m = 0; m < 4; ++m) { const size_t off = (size_t)(row0 + ai * HALF + m * 16) * D + u.pn * BM + cw;
#pragma unroll
                for (int bj = 0; bj < 2; ++bj) { float o[8];
#pragma unroll
                    for (int j = 0; j < 4; ++j) { o[j] = acc[ai][bj][m][0][j]; o[4 + j] = acc[ai][bj][m][1][j]; }
                    if (g.kind != E_MERGE0) { float mo[8], go[8]; unpack8(*(const u32x4*)(Mg + off + bj * HALF), mo); unpack8(*(const u32x4*)(G + off + bj * HALF), go);
#pragma unroll
                        for (int j = 0; j < 8; ++j) o[j] = (g.kind == E_MERGE1) ? go[j] * (mo[j] + o[j]) : mo[j] + go[j] * o[j]; }
                    *(u32x4*)(Mg + off + bj * HALF) = pack8(o); } }
    } break;
    default: break;
    }
}

template <bool SWAP, class JobFn>
__device__ __forceinline__ void gemm_run(LAS unsigned char* lds, const Job& g, const int G, const int tid, const JobFn& jobfn) {
    const int wid = __builtin_amdgcn_readfirstlane(tid >> 6), lane = tid & 63, wr = wid >> 2, wc = wid & 3, fr = lane & 15, fq = lane >> 4;
    const int K = g.K, nt = K / BK;
    unsigned voffA[2], voffB[2];
#pragma unroll
    for (int i = 0; i < 2; ++i) { int R, C; stage_rc(tid * 16 + i * 8192, R, C); const int Rb = (R & ~31) + perm32(R & 31);
        voffA[i] = (unsigned)(R * g.lda + C) * 2u; voffB[i] = (unsigned)(Rb * g.ldb + C) * 2u; }
    const size_t kstep = (size_t)(BK * 2);
    const size_t hstepA = (size_t)HALF * g.lda * 2, hstepB = (size_t)HALF * g.ldb * 2;
    const unsigned ldsw = (unsigned)wid * 1024u;
    const int aoff = lds_byte(wr * 64 + fr, fq * 8), boff = lds_byte(wc * 32 + fr, fq * 8);
#define PG8_SA(b, h) (((b) * 2 + (h)) * HTB)
#define PG8_SB(b, h) ((4 + (b) * 2 + (h)) * HTB)
#define PG8_STAGE(bufoff, gbase, voff) do { _Pragma("unroll") for (int _i = 0; _i < 2; ++_i) \
        __builtin_amdgcn_global_load_lds((const unsigned*)((const char*)(gbase) + (voff)[_i]), (LAS unsigned*)(lds + (bufoff) + ldsw + _i * 8192), 16, 0, 0); } while (0)
#define PG8_LDA(dst, b, h) do { _Pragma("unroll") for (int m = 0; m < 4; ++m) _Pragma("unroll") for (int k = 0; k < 2; ++k) dst[m][k] = *(const LAS bf16x8*)(lds + PG8_SA(b, h) + aoff + m * 2048 + k * 1024); } while (0)
#define PG8_LDB(dst, b, h) do { _Pragma("unroll") for (int n = 0; n < 2; ++n) _Pragma("unroll") for (int k = 0; k < 2; ++k) dst[n][k] = *(const LAS bf16x8*)(lds + PG8_SB(b, h) + boff + n * 2048 + k * 1024); } while (0)
#define PG8_MMA(ai, bj, At, Bt) do { __builtin_amdgcn_s_setprio(1); \
        if (SWAP) { _Pragma("unroll") for (int m = 0; m < 4; ++m) _Pragma("unroll") for (int n = 0; n < 2; ++n) _Pragma("unroll") for (int k = 0; k < 2; ++k) \
            acc[ai][bj][m][n] = __builtin_amdgcn_mfma_f32_16x16x32_bf16(At[m][k], Bt[n][k], acc[ai][bj][m][n], 0, 0, 0); } \
        else { _Pragma("unroll") for (int m = 0; m < 4; ++m) _Pragma("unroll") for (int n = 0; n < 2; ++n) _Pragma("unroll") for (int k = 0; k < 2; ++k) \
            acc[ai][bj][m][n] = __builtin_amdgcn_mfma_f32_16x16x32_bf16(Bt[n][k], At[m][k], acc[ai][bj][m][n], 0, 0, 0); } \
        __builtin_amdgcn_s_setprio(0); } while (0)
#define PG8_WAIT_V(n) asm volatile("s_waitcnt vmcnt(" #n ")" ::: "memory")
#define PG8_WAIT_L(n) asm volatile("s_waitcnt lgkmcnt(" #n ")" ::: "memory")
#define PG8_BAR __builtin_amdgcn_s_barrier()
#define PG8_SCHED __builtin_amdgcn_sched_barrier(0)
    Unit cur, nxt; int ui = 0;
    if (!next_unit(g, G, 0, cur)) return;
    Acc acc;
#pragma unroll
    for (int a = 0; a < 2; ++a)
#pragma unroll
        for (int b = 0; b < 2; ++b)
#pragma unroll
            for (int m = 0; m < 4; ++m)
#pragma unroll
                for (int n = 0; n < 2; ++n) acc[a][b][m][n] = (f32x4){0.f, 0.f, 0.f, 0.f};
    bf16x8 At[4][2], B0[2][2], B1[2][2];
    const size_t tstepA = (size_t)BM * g.lda * 2, tstepB = (size_t)BM * g.ldb * 2;
    const char* cA = (const char*)g.A + (size_t)cur.pm * tstepA; const char* cB = (const char*)g.Bt + (size_t)cur.pn * tstepB;
    PG8_STAGE(PG8_SB(0, 0), cB, voffB); PG8_STAGE(PG8_SA(0, 0), cA, voffA); PG8_STAGE(PG8_SB(0, 1), cB + hstepB, voffB); PG8_STAGE(PG8_SA(0, 1), cA + hstepA, voffA);
    if (wr == 1) PG8_BAR;
    PG8_WAIT_V(4); PG8_BAR;
    PG8_STAGE(PG8_SB(1, 0), cB + kstep, voffB); PG8_STAGE(PG8_SA(1, 0), cA + kstep, voffA); PG8_STAGE(PG8_SB(1, 1), cB + hstepB + kstep, voffB);
    PG8_WAIT_V(6); PG8_BAR;
    for (;;) {
        const bool has_next = next_unit(g, G, ui + 1, nxt);
        const char* nA = has_next ? (const char*)g.A + (size_t)nxt.pm * tstepA : cA; const char* nB = has_next ? (const char*)g.Bt + (size_t)nxt.pn * tstepB : cB;
#pragma unroll 1
        for (int t = 0; t < nt; t += 2) {
            const bool last = (t == nt - 2);
            const char* a1 = cA + (size_t)(t + 1) * kstep;
            const char* a2 = last ? nA : cA + (size_t)(t + 2) * kstep; const char* b2 = last ? nB : cB + (size_t)(t + 2) * kstep;
            const char* a3 = a2 + kstep; const char* b3 = b2 + kstep;
            PG8_LDB(B0, 0, 0); PG8_SCHED; PG8_LDA(At, 0, 0); PG8_STAGE(PG8_SA(1, 1), a1 + hstepA, voffA);
            PG8_WAIT_L(8); PG8_BAR; PG8_WAIT_L(0); PG8_MMA(0, 0, At, B0); PG8_BAR; PG8_SCHED;
            PG8_LDB(B1, 0, 1); PG8_STAGE(PG8_SB(0, 0), b2, voffB);
            PG8_BAR; PG8_WAIT_L(0); PG8_MMA(0, 1, At, B1); PG8_BAR;
            PG8_LDA(At, 0, 1); PG8_STAGE(PG8_SA(0, 0), a2, voffA);
            PG8_BAR; PG8_WAIT_L(0); PG8_MMA(1, 0, At, B0); PG8_BAR; PG8_SCHED;
            PG8_STAGE(PG8_SB(0, 1), b2 + hstepB, voffB);
            PG8_WAIT_V(6); PG8_BAR; PG8_MMA(1, 1, At, B1); PG8_BAR;
            PG8_LDB(B0, 1, 0); PG8_SCHED; PG8_LDA(At, 1, 0); PG8_STAGE(PG8_SA(0, 1), a2 + hstepA, voffA);
            PG8_WAIT_L(8); PG8_BAR; PG8_WAIT_L(0); PG8_MMA(0, 0, At, B0); PG8_BAR; PG8_SCHED;
            PG8_LDB(B1, 1, 1); PG8_STAGE(PG8_SB(1, 0), b3, voffB);
            PG8_BAR; PG8_WAIT_L(0); PG8_MMA(0, 1, At, B1); PG8_BAR;
            PG8_LDA(At, 1, 1); PG8_STAGE(PG8_SA(1, 0), a3, voffA);
            PG8_BAR; PG8_WAIT_L(0); PG8_MMA(1, 0, At, B0); PG8_BAR; PG8_SCHED;
            PG8_STAGE(PG8_SB(1, 1), b3 + hstepB, voffB);
            PG8_WAIT_V(6); PG8_BAR; PG8_MMA(1, 1, At, B1); PG8_BAR;
        }
        { Job ge; jobfn(ge); epilogue<SWAP>(ge, acc, cur, wr, wc, fr, fq); }
        if (!has_next) break;
#pragma unroll
        for (int a = 0; a < 2; ++a)
#pragma unroll
            for (int b = 0; b < 2; ++b)
#pragma unroll
                for (int m = 0; m < 4; ++m)
#pragma unroll
                    for (int n = 0; n < 2; ++n) acc[a][b][m][n] = (f32x4){0.f, 0.f, 0.f, 0.f};
        cur = nxt; cA = nA; cB = nB; ++ui;
    }
    PG8_WAIT_V(0);
    if (wr == 0) PG8_BAR;
    PG8_BAR;
#undef PG8_SA
#undef PG8_SB
#undef PG8_STAGE
#undef PG8_LDA
#undef PG8_LDB
#undef PG8_MMA
#undef PG8_WAIT_V
#undef PG8_WAIT_L
#undef PG8_BAR
#undef PG8_SCHED
}
}

#define XB_TMO      128
#define XB_XCNT(j)  (256  + 64 * (j))
#define XB_XSUB(j)  (1280 + 64 * (j))
#define XB_XGEN(j)  (2304 + 64 * (j))
#define XB_TOP      3328
#define XB_TOPGEN   3392
#define XCD_BAR_WORDS 3456
#define XB_SPIN_CAP (1u << 20)
__device__ __forceinline__ unsigned xb_ld(unsigned* p)              { return __hip_atomic_load(p, __ATOMIC_RELAXED, __HIP_MEMORY_SCOPE_AGENT); }
__device__ __forceinline__ unsigned xb_add(unsigned* p, unsigned v) { return __hip_atomic_fetch_add(p, v, __ATOMIC_RELAXED, __HIP_MEMORY_SCOPE_AGENT); }
__device__ __forceinline__ unsigned xb_xcc_id() { return (unsigned)__builtin_amdgcn_s_getreg((3 << 11) | 20) & 0xFu; }
#define XB_SPIN(cond, bar) do { unsigned _sp = 0; while (cond) { __builtin_amdgcn_s_sleep(1); \
    if ((++_sp & 255u) == 0u) { if (xb_ld(&(bar)[XB_TMO])) break; if (_sp > XB_SPIN_CAP) { atomicAdd(&(bar)[XB_TMO], 1u); break; } } } } while (0)
struct XcdBarrier { unsigned* bar; unsigned x; volatile LAS unsigned* st; };
__device__ __forceinline__ XcdBarrier xcd_barrier_post(unsigned* bar, volatile LAS unsigned* st) {
    XcdBarrier b; b.bar = bar; b.x = xb_xcc_id(); b.st = st;
    if (threadIdx.x == 0) (void)xb_add(&bar[XB_XCNT(b.x)], 1u);
    return b;
}
__device__ __forceinline__ void xcd_barrier_complete(unsigned* bar, unsigned x, unsigned& nloc, unsigned& nx) {
    const unsigned G = gridDim.x * gridDim.y * gridDim.z;
    unsigned sum, cnt, mine, sp = 0u;
    for (;;) {
        sum = 0u; cnt = 0u; mine = 0u;
#pragma unroll
        for (unsigned j = 0; j < 16; ++j) { const unsigned c = xb_ld(&bar[XB_XCNT(j)]); sum += c; cnt += (c > 0u) ? 1u : 0u; mine = (j == x) ? c : mine; }
        if (sum == G) break;
        __builtin_amdgcn_s_sleep(1);
        if ((++sp & 255u) == 0u) { if (xb_ld(&bar[XB_TMO])) break; if (sp > XB_SPIN_CAP) { atomicAdd(&bar[XB_TMO], 1u); break; } }
    }
    nloc = mine > 0u ? mine : 1u; nx = cnt > 0u ? cnt : 1u;
}
__device__ __forceinline__ void xcd_barrier(const XcdBarrier& b, const bool leader) {
    asm volatile("s_waitcnt vmcnt(0)" ::: "memory");
    __syncthreads();
    if (leader) {
        unsigned* bar = b.bar;
        __builtin_amdgcn_s_waitcnt(0);
        unsigned nloc = b.st[0], nx = b.st[1];
        if (nloc == 0u) { xcd_barrier_complete(bar, b.x, nloc, nx); b.st[0] = nloc; b.st[1] = nx; }
        const unsigned old = xb_add(&bar[XB_XSUB(b.x)], 1u);
        const unsigned gen = old / nloc;
        if (old + 1u == (gen + 1u) * nloc) {
            __builtin_amdgcn_fence(__ATOMIC_RELEASE, "agent");
            asm volatile("s_waitcnt vmcnt(0)" ::: "memory");
            const unsigned og = xb_add(&bar[XB_TOP], 1u);
            const unsigned tg = og / nx;
            if (og + 1u == (tg + 1u) * nx) xb_add(&bar[XB_TOPGEN], 1u);
            else XB_SPIN(xb_ld(&bar[XB_TOPGEN]) == tg, bar);
            __builtin_amdgcn_fence(__ATOMIC_ACQUIRE, "agent");
            xb_add(&bar[XB_XGEN(b.x)], 1u);
            asm volatile("s_waitcnt vmcnt(0)" ::: "memory");
        } else {
            XB_SPIN(xb_ld(&bar[XB_XGEN(b.x)]) == gen, bar);
            __builtin_amdgcn_fence(__ATOMIC_ACQUIRE, "agent");
            asm volatile("s_waitcnt vmcnt(0)" ::: "memory");
        }
    }
    __syncthreads();
}

struct Frame {
    LAS unsigned char* lds; GAS unsigned char* ws; int tid, lane, wave, c, G, dry;
};
#define WSP(T_, off) ((T_*)(F.ws + (off)))

__device__ __forceinline__ void transpose_item(const float* W, int ld, int K, int srccol0, bf16_t* WT, int n0, int k0, LAS float* scr, int lane) {
    const int lr = lane >> 4, lc = (lane & 15) * 4;
#pragma unroll 8
    for (int i = 0; i < 16; ++i) { const int kk = 4 * i + lr; const f32x4 v = *(const f32x4*)(W + (size_t)(k0 + kk) * ld + srccol0 + lc);
        LAS float* d = scr + kk * 65 + lc; d[0] = v[0]; d[1] = v[1]; d[2] = v[2]; d[3] = v[3]; }
    asm volatile("s_waitcnt lgkmcnt(0)" ::: "memory");
    const int cc = lane & 7;
#pragma unroll
    for (int j = 0; j < 8; ++j) { const int n = (lane >> 3) + 8 * j; const LAS float* s = scr + (8 * cc) * 65 + n;
        u32x4 o; o.x = pk2(s[0 * 65], s[1 * 65]); o.y = pk2(s[2 * 65], s[3 * 65]); o.z = pk2(s[4 * 65], s[5 * 65]); o.w = pk2(s[6 * 65], s[7 * 65]);
        *(u32x4*)(WT + (size_t)(n0 + n) * K + k0 + 8 * cc) = o; }
    asm volatile("s_waitcnt lgkmcnt(0)" ::: "memory");
}
struct CJob { const float* src; int ld, K, N; bf16_t* dst; int map; };
__device__ __forceinline__ CJob conv_job(PRef P, const Frame& F, int job) {
    CJob j{};
    switch (job) {
        case 0: j = CJob{gp(P.ffn1_w_gu), 2 * DFF, D, 2 * DFF, WSP(bf16_t, WS_WGU), 1}; break;
        case 1: j = CJob{gp(P.ffn1_w_down), D, DFF, D, WSP(bf16_t, WS_WDN), 0}; break;
        case 2: j = CJob{gp(P.w_in), 11272, D, 11264, WSP(bf16_t, WS_WIN), 2}; break;
        case 3: case 4: case 5: case 6: j = CJob{gp(P.m_wv) + (size_t)(job - 3) * 512 * 512, 512, 512, 512, WSP(bf16_t, WS_WVT) + (size_t)(job - 3) * 512 * 512, 0}; break;
        case 7: j = CJob{gp(P.w_mem_kv), 2048, D, 2048, WSP(bf16_t, WS_WMKV), 0}; break;
        case 8: j = CJob{gp(P.w_branch_m), D, 2048, D, WSP(bf16_t, WS_WBM), 0}; break;
        case 9: j = CJob{gp(P.w_branch_a), D, D, D, WSP(bf16_t, WS_WBA), 0}; break;
        case 10: j = CJob{gp(P.w_branch_x), D, D, D, WSP(bf16_t, WS_WBX), 0}; break;
        case 11: j = CJob{gp(P.w_out), D, D, D, WSP(bf16_t, WS_WOUT), 0}; break;
        case 12: j = CJob{gp(P.ffn2_w_gu), 2 * DFF, D, 2 * DFF, WSP(bf16_t, WS_WGU), 1}; break;
        default: j = CJob{gp(P.ffn2_w_down), D, DFF, D, WSP(bf16_t, WS_WDN), 0}; break;
    }
    return j;
}
__device__ __forceinline__ void convert_jobs(PRef P, const Frame& F, int job_lo, int job_hi) {
    LAS float* scr = (LAS float*)(F.lds + F.wave * 16640);
    const int gw = F.c * 8 + F.wave, NGW = F.G * 8;
    int base = 0;
    for (int job = job_lo; job < job_hi; ++job) {
        const CJob j = conv_job(P, F, job);
        const int nblk = j.N / 64, items = (j.K / 64) * nblk;
        int it = gw - (base % NGW); if (it < 0) it += NGW;
        for (; it < items; it += NGW) {
            const int kb = it / nblk, nb = it % nblk, n0 = nb * 64;
            int sc = n0;
            if (j.map == 1) { const int tile = n0 >> 8, r = n0 & 255; sc = (r < 128) ? tile * 128 + r : DFF + tile * 128 + (r - 128); }
            else if (j.map == 2) { sc = n0 < 4096 ? n0 : n0 + 8; }
            transpose_item(j.src, j.ld, j.K, sc, j.dst, n0, kb * 64, scr, F.lane);
        }
        base += items;
    }
}
__device__ __forceinline__ void rms_row_bf16(const float* xrow, const float* g, bf16_t* orow, int lane) {
    f32x4 v[4]; float s = 0.f;
#pragma unroll
    for (int j = 0; j < 4; ++j) { v[j] = ((const f32x4*)xrow)[lane + 64 * j]; s += (v[j][0] * v[j][0] + v[j][1] * v[j][1]) + (v[j][2] * v[j][2] + v[j][3] * v[j][3]); }
    const float r = 1.0f / sqrtf(wave_sum(s) * (1.f / D) + EPS);
#pragma unroll
    for (int j = 0; j < 4; ++j) { const f32x4 gv = ((const f32x4*)g)[lane + 64 * j]; u32x2 o; o.x = pk2(v[j][0] * r * gv[0], v[j][1] * r * gv[1]); o.y = pk2(v[j][2] * r * gv[2], v[j][3] * r * gv[3]);
        ((u32x2*)orow)[lane + 64 * j] = o; }
}
__device__ __forceinline__ void rowpass_bf16(const Frame& F, const float* X, const float* g, bf16_t* O, int rows) {
    const int lane = F.lane, stride = F.G * 8;
    f32x4 gv[4];
#pragma unroll
    for (int j = 0; j < 4; ++j) gv[j] = ((const f32x4*)g)[lane + 64 * j];
    for (int r0 = F.c * 8 + F.wave; r0 < rows; r0 += 4 * stride) {
        f32x4 v[4][4];
#pragma unroll
        for (int q = 0; q < 4; ++q) { const int r = r0 + q * stride;
#pragma unroll
            for (int j = 0; j < 4; ++j) v[q][j] = (r < rows) ? ((const f32x4*)(X + (size_t)r * D))[lane + 64 * j] : (f32x4){0.f, 0.f, 0.f, 0.f}; }
#pragma unroll
        for (int q = 0; q < 4; ++q) { const int r = r0 + q * stride; float s = 0.f;
#pragma unroll
            for (int j = 0; j < 4; ++j) s += (v[q][j][0] * v[q][j][0] + v[q][j][1] * v[q][j][1]) + (v[q][j][2] * v[q][j][2] + v[q][j][3] * v[q][j][3]);
            const float rr = 1.0f / sqrtf(wave_sum(s) * (1.f / D) + EPS);
            if (r < rows) {
#pragma unroll
                for (int j = 0; j < 4; ++j) { u32x2 o; o.x = pk2(v[q][j][0] * rr * gv[j][0], v[q][j][1] * rr * gv[j][1]); o.y = pk2(v[q][j][2] * rr * gv[j][2], v[q][j][3] * rr * gv[j][3]);
                    ((u32x2*)(O + (size_t)r * D))[lane + 64 * j] = o; } } }
    }
}
__device__ __forceinline__ void at_unit(PRef P, const Frame& F, int u) {
    const int h = u >> 6, tile = u & 63, n0 = (tile >> 3) * 64, k0 = (tile & 7) * 64;
    constexpr int LS = 36;
    LAS float* sK = (LAS float*)F.lds; LAS float* sQ = sK + 64 * LS;
    const float* Wk = gp(P.m_wk) + (size_t)h * 512 * 512; const float* Wq = gp(P.m_wq) + (size_t)h * 512 * 512;
    const int tn = F.tid >> 3, tk = F.tid & 7;
    float acc[8];
#pragma unroll
    for (int i = 0; i < 8; ++i) acc[i] = 0.f;
    const int lr = F.tid >> 3, lc = (F.tid & 7) * 4;
    f32x4 pk_ = *(const f32x4*)(Wk + (size_t)(n0 + lr) * 512 + lc), pq_ = *(const f32x4*)(Wq + (size_t)(k0 + lr) * 512 + lc);
#pragma unroll 1
    for (int j0 = 0; j0 < 512; j0 += 32) {
        __syncthreads();
        *(LAS f32x4*)(sK + lr * LS + lc) = pk_;
        *(LAS f32x4*)(sQ + lr * LS + lc) = pq_;
        { const int jn = (j0 + 32 < 512) ? j0 + 32 : j0; pk_ = *(const f32x4*)(Wk + (size_t)(n0 + lr) * 512 + jn + lc); pq_ = *(const f32x4*)(Wq + (size_t)(k0 + lr) * 512 + jn + lc); }
        __syncthreads();
#pragma unroll
        for (int jj = 0; jj < 32; jj += 4) { const f32x4 a = *(const LAS f32x4*)(sK + tn * LS + jj);
#pragma unroll
            for (int i = 0; i < 8; ++i) { const f32x4 q = *(const LAS f32x4*)(sQ + (tk + 8 * i) * LS + jj); acc[i] += (a[0] * q[0] + a[1] * q[1]) + (a[2] * q[2] + a[3] * q[3]); } }
    }
    bf16_t* AT = WSP(bf16_t, WS_AT) + (size_t)h * 512 * 512;
    const float sc = 0.044194173824159216f;
#pragma unroll
    for (int i = 0; i < 8; ++i) AT[(size_t)(n0 + tn) * 512 + k0 + tk + 8 * i] = (bf16_t)(pk2(acc[i] * sc, 0.f) & 0xffffu);
    __syncthreads();
}
__device__ __forceinline__ void bias_table(PRef P, const Frame& F) {
    float* TAB = WSP(float, WS_TAB);
    for (int e = F.tid; e < 8 * 128; e += 512) { const int h = e >> 7, n = e & 127; int bk;
        if (n < 16) bk = n; else { bk = 16 + (int)(logf((float)n / 16.f) / logf(8.f) * 16.f); bk = bk < 31 ? bk : 31; }
        TAB[e] = gp(P.rel_bias)[bk * 8 + h] * LOG2E; }
}
__device__ __forceinline__ void row2_phase(PRef P, const Frame& F) {
    LAS float* gw = (LAS float*)F.lds;
    for (int e = F.tid; e < 1024 * 8; e += 512) gw[e] = gp(P.w_in)[(size_t)(e >> 3) * 11272 + 4096 + (e & 7)];
    __syncthreads();
    const float* X = gp(P.out); bf16_t* H = WSP(bf16_t, WS_H); float* GATES = WSP(float, WS_GATES);
    for (int r = F.c * 8 + F.wave; r < T; r += F.G * 8) {
        const float* xrow = X + (size_t)r * D; const int lane = F.lane;
        f32x4 v[4]; float s = 0.f;
#pragma unroll
        for (int j = 0; j < 4; ++j) { v[j] = ((const f32x4*)xrow)[lane + 64 * j]; s += (v[j][0] * v[j][0] + v[j][1] * v[j][1]) + (v[j][2] * v[j][2] + v[j][3] * v[j][3]); }
        const float rr = 1.0f / sqrtf(wave_sum(s) * (1.f / D) + EPS);
        float ga[8];
#pragma unroll
        for (int q = 0; q < 8; ++q) ga[q] = 0.f;
#pragma unroll
        for (int j = 0; j < 4; ++j) { const f32x4 gv = ((const f32x4*)gp(P.mix_norm))[lane + 64 * j];
            float hv[4];
#pragma unroll
            for (int e = 0; e < 4; ++e) hv[e] = v[j][e] * rr * gv[e];
            u32x2 o; o.x = pk2(hv[0], hv[1]); o.y = pk2(hv[2], hv[3]); ((u32x2*)(H + (size_t)r * D))[lane + 64 * j] = o;
#pragma unroll
            for (int e = 0; e < 4; ++e) { const LAS f32x4* wp = (const LAS f32x4*)(gw + (size_t)(4 * (lane + 64 * j) + e) * 8); const f32x4 w0 = wp[0], w1 = wp[1];
                ga[0] += hv[e] * w0[0]; ga[1] += hv[e] * w0[1]; ga[2] += hv[e] * w0[2]; ga[3] += hv[e] * w0[3];
                ga[4] += hv[e] * w1[0]; ga[5] += hv[e] * w1[1]; ga[6] += hv[e] * w1[2]; ga[7] += hv[e] * w1[3]; } }
#pragma unroll
        for (int q = 0; q < 8; ++q) ga[q] = wave_sum(ga[q]);
        if (lane == 0) { *(f32x4*)(GATES + (size_t)r * 8) = (f32x4){ga[0], ga[1], ga[2], ga[3]}; *(f32x4*)(GATES + (size_t)r * 8 + 4) = (f32x4){ga[4], ga[5], ga[6], ga[7]}; }
    }
    __syncthreads();
}
__device__ __forceinline__ void gscan_unit(PRef P, const Frame& F, int u) {
    const int b = u >> 2, h = u & 3;
    LAS float* bb = (LAS float*)F.lds; LAS float* aa = bb + SEQ; LAS float* pp = aa + SEQ; LAS float* mprev = pp + SEQ; LAS float* mlarr = mprev + 32;
    const float* GATES = WSP(float, WS_GATES);
    const float bi = gp(P.b_if)[h], bf = gp(P.b_if)[4 + h];
    __syncthreads();
    {
        const int t0 = F.tid * 8;
        float lf[8], ig[8];
#pragma unroll
        for (int i = 0; i < 8; ++i) { const float* gp = GATES + ((size_t)b * SEQ + t0 + i) * 8; const float ip = gp[h] + bi, fp = gp[4 + h] + bf;
            lf[i] = fminf(fp, 0.f) - log1pf(expf(-fabsf(fp))); ig[i] = ip; }
        float run = 0.f;
#pragma unroll
        for (int i = 0; i < 8; ++i) { run += lf[i]; lf[i] = run; }
        float off = run;
        off += row_shr<1>(off, 0.f); off += row_shr<2>(off, 0.f); off += row_shr<4>(off, 0.f); off += row_shr<8>(off, 0.f);
        off -= run;
        float pm = -INFINITY; float av[8];
#pragma unroll
        for (int i = 0; i < 8; ++i) { lf[i] += off; av[i] = ig[i] - lf[i]; pm = fmaxf(pm, av[i]); ig[i] = pm; }
        float pmx = pm;
        pmx = fmaxf(pmx, row_shr<1>(pmx, -INFINITY)); pmx = fmaxf(pmx, row_shr<2>(pmx, -INFINITY)); pmx = fmaxf(pmx, row_shr<4>(pmx, -INFINITY)); pmx = fmaxf(pmx, row_shr<8>(pmx, -INFINITY));
        const float pex = row_shr<1>(pmx, -INFINITY);
#pragma unroll
        for (int i = 0; i < 8; ++i) { bb[t0 + i] = lf[i]; aa[t0 + i] = av[i]; pp[t0 + i] = fmaxf(ig[i], pex); }
    }
    __syncthreads();
    if (F.tid == 0) { float m = 0.f; float* DEC = WSP(float, WS_DEC) + u * 32;
        for (int c = 0; c < 32; ++c) { mprev[c] = m; const float ML = fmaxf(m, pp[c * 128 + 127]); mlarr[c] = ML; DEC[c] = expf(m - ML); m = bb[c * 128 + 127] + ML; } }
    __syncthreads();
    float *AS = WSP(float, WS_AS), *MT = WSP(float, WS_MT), *WI = WSP(float, WS_WI), *LBv = WSP(float, WS_LB), *WSv = WSP(float, WS_WS);
    for (int t = F.tid; t < SEQ; t += 512) { const int c = t >> 7; const float mp = mprev[c], Mt = fmaxf(mp, pp[t]); const size_t o = ((size_t)b * SEQ + t) * 4 + h;
        AS[o] = aa[t]; MT[o] = Mt; WI[o] = expf(mp - Mt); LBv[o] = expf(-(bb[t] + Mt)); WSv[o] = expf(aa[t] - mlarr[c]); }
    __syncthreads();
}
__device__ __forceinline__ void conv_unit(PRef P, const Frame& F, int pair, int u) {
    const int cb = u & 15, c = (u >> 4) & 31, b = u >> 9;
    const bf16_t* XM = WSP(bf16_t, WS_A); bf16_t* XC = WSP(bf16_t, WS_C); bf16_t* XT = WSP(bf16_t, WS_D); const float* WSv = WSP(float, WS_WS);
    LAS bf16_t* tile = (LAS bf16_t*)F.lds;
    const int cg = F.tid & 7, rg = F.tid >> 3;
    const int lc = cb * 64 + cg * 8, gc = pair * 1024 + lc, hg = pair * 2 + (lc >> 9);
    float w[4][8], bs[8];
#pragma unroll
    for (int j = 0; j < 4; ++j) { const f32x4 a = *(const f32x4*)(gp(P.m_conv_w) + (size_t)j * 2048 + gc), bq = *(const f32x4*)(gp(P.m_conv_w) + (size_t)j * 2048 + gc + 4);
        w[j][0] = a[0]; w[j][1] = a[1]; w[j][2] = a[2]; w[j][3] = a[3]; w[j][4] = bq[0]; w[j][5] = bq[1]; w[j][6] = bq[2]; w[j][7] = bq[3]; }
    { const f32x4 a = *(const f32x4*)(gp(P.m_conv_b) + gc), bq = *(const f32x4*)(gp(P.m_conv_b) + gc + 4); bs[0] = a[0]; bs[1] = a[1]; bs[2] = a[2]; bs[3] = a[3]; bs[4] = bq[0]; bs[5] = bq[1]; bs[6] = bq[2]; bs[7] = bq[3]; }
    const int s0 = c * 128 + 2 * rg;
    float xin[5][8];
#pragma unroll
    for (int r = 0; r < 5; ++r) { const int sp = s0 - 3 + r;
        u32x4 v = (u32x4){0u, 0u, 0u, 0u};
        if (sp >= 0) v = *(const u32x4*)(XM + ((size_t)b * SEQ + sp) * D + lc);
        xin[r][0] = bflo(v.x); xin[r][1] = bfhi(v.x); xin[r][2] = bflo(v.y); xin[r][3] = bfhi(v.y); xin[r][4] = bflo(v.z); xin[r][5] = bfhi(v.z); xin[r][6] = bflo(v.w); xin[r][7] = bfhi(v.w); }
    __syncthreads();
#pragma unroll
    for (int r = 0; r < 2; ++r) { float o[8]; const size_t tg = (size_t)b * SEQ + s0 + r; const float wsv = WSv[tg * 4 + hg];
#pragma unroll
        for (int e = 0; e < 8; ++e) { float y = bs[e];
#pragma unroll
            for (int j = 0; j < 4; ++j) y += w[j][e] * xin[r + j][e];
            o[e] = y * sigmoidf_(y); }
        u32x4 ov; ov.x = pk2(o[0], o[1]); ov.y = pk2(o[2], o[3]); ov.z = pk2(o[4], o[5]); ov.w = pk2(o[6], o[7]);
        *(u32x4*)(XC + tg * D + lc) = ov;
#pragma unroll
        for (int e = 0; e < 8; e += 2) { const unsigned pq = pk2(o[e] * wsv, o[e + 1] * wsv); tile[(cg * 8 + e) * 136 + 2 * rg + r] = (bf16_t)(pq & 0xffffu); tile[(cg * 8 + e + 1) * 136 + 2 * rg + r] = (bf16_t)(pq >> 16); } }
    __syncthreads();
    { const int d = F.tid & 63, sgq = F.tid >> 6; const int dl = (cb * 64 + d) & 511, hz = (cb * 64) >> 9;
        bf16_t* dst = XT + ((size_t)b * 2 + hz) * 512 * SEQ;
#pragma unroll
        for (int q = 0; q < 2; ++q) { const int sg = sgq + 8 * q; *(u32x4*)(dst + ((size_t)(c * 16 + sg) * 512 + dl) * 8) = *(const LAS u32x4*)(tile + d * 136 + sg * 8); } }
}
__device__ __forceinline__ void spre_unit(PRef P, const Frame& F, int pair, int u) {
    const int c = u & 31, hz = (u >> 5) & 1, b = u >> 6, hg = pair * 2 + hz;
    const bf16_t* Q = WSP(bf16_t, WS_A); const bf16_t* XC = WSP(bf16_t, WS_C); bf16_t* S = WSP(bf16_t, WS_S);
    const float *AS = WSP(float, WS_AS), *MT = WSP(float, WS_MT); float* SDEN = WSP(float, WS_SDEN);
    constexpr int RS = 1040;
    LAS unsigned char* xt = F.lds; LAS float* las = (LAS float*)(F.lds + 128 * RS);
    const size_t t0 = (size_t)b * SEQ + c * 128;
    __syncthreads();
#pragma unroll 4
    for (int i = 0; i < 16; ++i) { const int p = F.tid + 512 * i, row = p >> 6, pc = p & 63;
        *(LAS u32x4*)(xt + row * RS + pc * 16) = *(const u32x4*)(XC + (t0 + row) * D + hz * 512 + pc * 8); }
    if (F.tid < 128) las[F.tid] = AS[(t0 + F.tid) * 4 + hg];
    const int w = F.wave, fr = F.lane & 15, fq = F.lane >> 4;
    bf16x8 qf[16];
#pragma unroll
    for (int kk = 0; kk < 16; ++kk) qf[kk] = *(const bf16x8*)(Q + ((size_t)b * 2 + hz) * 512 * SEQ + ((size_t)(4 * kk + fq) * SEQ + c * 128 + 16 * w + fr) * 8);
    const float mt = MT[(t0 + 16 * w + fr) * 4 + hg];
    __syncthreads();
    float rs = 0.f; const int tl = 16 * w + fr;
    bf16_t* Sb = S + (((size_t)b * 2 + hz) * 32 + c) * 128 * 128;
#pragma unroll
    for (int n = 0; n < 8; ++n) {
        f32x4 acc = (f32x4){0.f, 0.f, 0.f, 0.f};
        if (n <= w) {
#pragma unroll
            for (int kk = 0; kk < 16; ++kk) { const bf16x8 xf = *(const LAS bf16x8*)(xt + (16 * n + fr) * RS + (32 * kk + 8 * fq) * 2); acc = __builtin_amdgcn_mfma_f32_16x16x32_bf16(xf, qf[kk], acc, 0, 0, 0); }
        }
        float o[4];
#pragma unroll
        for (int i = 0; i < 4; ++i) { const int sl = 16 * n + 4 * fq + i; o[i] = (n <= w && sl <= tl) ? acc[i] * __expf(las[sl] - mt) : 0.f; rs += o[i]; }
        u32x2 ov; ov.x = pk2(o[0], o[1]); ov.y = pk2(o[2], o[3]); *(u32x2*)(Sb + ((2 * n + (fq >> 1)) * 128 + tl) * 8 + 4 * (fq & 1)) = ov;
    }
    rs += __shfl_xor(rs, 16); rs += __shfl_xor(rs, 32);
    if (fq == 0) SDEN[(t0 + tl) * 4 + hg] = rs;
}
constexpr int SCAN_NT = 1;
constexpr int SCAN_NE = 32 / SCAN_NT;
static_assert(SCAN_NE == SCAN_PARTS, "SCAN_PARTS must equal 32 / SCAN_NT");
template <int NT>
__device__ __forceinline__ void scan_unit(PRef P, const Frame& F, int pair, int u) {
    const int xc8 = u & 7, eb = u >> 3, b = xc8 >> 1, hz = xc8 & 1, hg = pair * 2 + hz, e0 = eb * 16 * NT;
    const bf16_t* Q = WSP(bf16_t, WS_A); const bf16_t* VT = WSP(bf16_t, WS_B); bf16_t* NUM = WSP(bf16_t, WS_C); const bf16_t* XT = WSP(bf16_t, WS_D); const bf16_t* S = WSP(bf16_t, WS_S);
    const float *WI = WSP(float, WS_WI), *DEC = WSP(float, WS_DEC) + (b * 4 + hg) * 32; float* SSQ = WSP(float, WS_SSQ); bf16_t* DENP = WSP(bf16_t, WS_DENP);
    constexpr int RS = 1040, GM = 2 * NT - 1;
    LAS unsigned char* ct = F.lds;
    LAS float* nl = (LAS float*)(F.lds + 32 * RS);
    const int w = F.wave, fr = F.lane & 15, fq = F.lane >> 4;
    __syncthreads();
    for (int e = F.tid; e < (32 * RS + 128) / 16; e += 512) *(LAS u32x4*)(ct + e * 16) = (u32x4){0u, 0u, 0u, 0u};
    f32x4 Cacc[4][NT];
#pragma unroll
    for (int m = 0; m < 4; ++m)
#pragma unroll
        for (int n = 0; n < NT; ++n) Cacc[m][n] = (f32x4){0.f, 0.f, 0.f, 0.f};
    float nst = 0.f;
    const size_t bh = (size_t)b * 2 + hz;
    __syncthreads();
    bf16x8 qf[16], sf[4], vf[NT][4], xf[4][4];
    const bf16_t* qp = Q + bh * 512 * SEQ + ((size_t)fq * SEQ + 16 * w + fr) * 8;
    const bf16_t* sp = S + (bh * 32) * 128 * 128 + ((size_t)fq * 128 + 16 * w + fr) * 8;
    const bf16_t* vp = VT + bh * 512 * SEQ + ((size_t)fq * 512 + e0 + fr) * 8;
    const bf16_t* xp = XT + bh * 512 * SEQ + ((size_t)fq * 512 + 64 * w + fr) * 8;
    const bf16_t* qn = Q + bh * 512 * SEQ + ((size_t)(2 * NT * eb + (fq & GM)) * SEQ + 16 * w + fr) * 8;
    const int wstar = (NT == 1) ? (eb >> 2) : (eb >> 1), mstar = (NT == 1) ? (eb & 3) : (eb & 1) * 2;
    const int cmul = F.dry ? 0 : 1;
#define SCAN_LDQ(c_) do { _Pragma("unroll") for (int kk = 0; kk < 16; ++kk) qf[kk] = *(const bf16x8*)(qp + ((size_t)4 * kk * SEQ + ((c_) * cmul) * 128) * 8); } while (0)
#define SCAN_LDX(c_) do { _Pragma("unroll") for (int m = 0; m < 4; ++m) _Pragma("unroll") for (int ks = 0; ks < 4; ++ks) xf[m][ks] = *(const bf16x8*)(xp + ((size_t)(((c_) * cmul) * 16 + 4 * ks) * 512 + 16 * m) * 8); } while (0)
#define SCAN_LDV(c_) do { _Pragma("unroll") for (int n = 0; n < NT; ++n) _Pragma("unroll") for (int ks = 0; ks < 4; ++ks) vf[n][ks] = *(const bf16x8*)(vp + ((size_t)(((c_) * cmul) * 16 + 4 * ks) * 512 + 16 * n) * 8); } while (0)
    constexpr bool PFQ = (NT == 1);
    if (PFQ) { SCAN_LDQ(0); SCAN_LDX(0); }
#pragma unroll 1
    for (int c = 0; c < 32; ++c) {
        const size_t t0 = (size_t)b * SEQ + c * 128, tt = t0 + 16 * w + fr;
        const float wi = WI[tt * 4 + hg], dec = DEC[c];
        if (!PFQ) SCAN_LDQ(c);
        SCAN_LDV(c);
#pragma unroll
        for (int ks = 0; ks < 4; ++ks) sf[ks] = *(const bf16x8*)(sp + (size_t)(c * cmul) * 128 * 128 + 4 * ks * 128 * 8);
        const bf16x8 qn8 = *(const bf16x8*)(qn + (size_t)(c * cmul) * 128 * 8);
        f32x4 ai[NT], ae[NT];
#pragma unroll
        for (int n = 0; n < NT; ++n) { ai[n] = (f32x4){0.f, 0.f, 0.f, 0.f}; ae[n] = ai[n]; }
#pragma unroll
        for (int kk = 0; kk < 16; ++kk)
#pragma unroll
            for (int n = 0; n < NT; ++n) { const bf16x8 cf = *(const LAS bf16x8*)(ct + (16 * n + fr) * RS + (32 * kk + 8 * fq) * 2); ae[n] = __builtin_amdgcn_mfma_f32_16x16x32_bf16(cf, qf[kk], ae[n], 0, 0, 0); }
        const int cn = (c + 1 < 32) ? c + 1 : 31;
        __builtin_amdgcn_sched_barrier(0);
        if (PFQ) SCAN_LDQ(cn);
        else SCAN_LDX(c);
        __builtin_amdgcn_sched_barrier(0);
#pragma unroll
        for (int ks = 0; ks < 4; ++ks)
#pragma unroll
            for (int n = 0; n < NT; ++n) ai[n] = __builtin_amdgcn_mfma_f32_16x16x32_bf16(vf[n][ks], sf[ks], ai[n], 0, 0, 0);
        {
            const f32x4 n0 = *(const LAS f32x4*)(nl + 8 * (fq & GM)), n1 = *(const LAS f32x4*)(nl + 8 * (fq & GM) + 4);
            float dp = 0.f;
#pragma unroll
            for (int j = 0; j < 4; ++j) { dp += __uint_as_float(((unsigned)(unsigned short)qn8[j]) << 16) * n0[j]; dp += __uint_as_float(((unsigned)(unsigned short)qn8[4 + j]) << 16) * n1[j]; }
            dp += __shfl_xor(dp, 16); if (NT == 2) dp += __shfl_xor(dp, 32);
            if (fq == 0 && !(F.dry && DRYMODE == 2)) DENP[(tt * 2 + hz) * 32 + eb] = (bf16_t)(pk2(wi * dp, 0.f) & 0xffffu);
        }
        float ss = 0.f;
#pragma unroll
        for (int n = 0; n < NT; ++n) { float o[4];
#pragma unroll
            for (int i = 0; i < 4; ++i) { o[i] = ai[n][i] + wi * ae[n][i]; ss += o[i] * o[i]; }
            u32x2 ov; ov.x = pk2(o[0], o[1]); ov.y = pk2(o[2], o[3]);
            if (!(F.dry && DRYMODE == 2)) *(u32x2*)(NUM + tt * D + hz * 512 + e0 + 16 * n + 4 * fq) = ov; }
        ss += __shfl_xor(ss, 16); ss += __shfl_xor(ss, 32);
        if (fq == 0 && !(F.dry && DRYMODE == 2)) SSQ[(tt * 2 + hz) * 32 + eb] = ss;
#pragma unroll
        for (int m = 0; m < 4; ++m)
#pragma unroll
            for (int n = 0; n < NT; ++n) { Cacc[m][n] = Cacc[m][n] * dec;
#pragma unroll
                for (int ks = 0; ks < 4; ++ks) Cacc[m][n] = __builtin_amdgcn_mfma_f32_16x16x32_bf16(xf[m][ks], vf[n][ks], Cacc[m][n], 0, 0, 0); }
        if (w == wstar) {
            float r0 = 0.f, r1 = 0.f;
#define SCAN_RS(acc_, m_) do { _Pragma("unroll") for (int ks = 0; ks < 4; ++ks) _Pragma("unroll") for (int j = 0; j < 8; ++j) acc_ += __uint_as_float(((unsigned)(unsigned short)xf[m_][ks][j]) << 16); } while (0)
            if (NT == 1) { if (mstar == 0) SCAN_RS(r0, 0); else if (mstar == 1) SCAN_RS(r0, 1); else if (mstar == 2) SCAN_RS(r0, 2); else SCAN_RS(r0, 3); }
            else { if (mstar == 0) { SCAN_RS(r0, 0); SCAN_RS(r1, 1); } else { SCAN_RS(r0, 2); SCAN_RS(r1, 3); } }
#undef SCAN_RS
            r0 += __shfl_xor(r0, 16); r0 += __shfl_xor(r0, 32);
            if (NT == 2) { r1 += __shfl_xor(r1, 16); r1 += __shfl_xor(r1, 32); }
            nst = dec * nst + ((NT == 2 && (fq & 2)) ? r1 : r0);
        }
        __builtin_amdgcn_sched_barrier(0);
        if (PFQ) SCAN_LDX(cn);
        __builtin_amdgcn_sched_barrier(0);
        __builtin_amdgcn_s_waitcnt(0xC07F);
        __builtin_amdgcn_s_barrier();
#pragma unroll
        for (int m = 0; m < 4; ++m)
#pragma unroll
            for (int n = 0; n < NT; ++n) { u32x2 cv; cv.x = pk2(Cacc[m][n][0], Cacc[m][n][1]); cv.y = pk2(Cacc[m][n][2], Cacc[m][n][3]);
                *(LAS u32x2*)(ct + (16 * n + fr) * RS + (64 * w + 16 * m + 4 * fq) * 2) = cv; }
        if (NT == 1) { if (w == wstar && fq == 0) nl[fr] = nst; }
        else { if (w == wstar && (fq & 1) == 0) nl[16 * (fq >> 1) + fr] = nst; }
        __builtin_amdgcn_s_waitcnt(0xC07F);
        __builtin_amdgcn_s_barrier();
    }
#undef SCAN_LDQ
#undef SCAN_LDX
#undef SCAN_LDV
}

template <int DQ, int NDV, bool DIFF>
__device__ __forceinline__ void attn_block(const Frame& F, const bf16_t* Qb, int ldq, const bf16_t* Kb, int ldk, const bf16_t* Vtb, int ldv, bf16_t* Ob, int ldo,
                                           int q0, int nkt, float scale2, const float* tabg, float lam, const float* gnorm) {
    constexpr bool GL = DIFF;
    constexpr int KB = DIFF ? 256 : 512, KROW = GL ? 256 : KB + 16, VROW = GL ? 128 : 136, KTILE = 64 * KROW, VTILE = NDV * VROW, STAGE = KTILE + VTILE;
    constexpr int NK = (64 * KB / 16) / 512, NV = (NDV * 8) / 512, KPR = KB / 16, NST = GL ? 4 : 2;
    LAS unsigned char* lds = F.lds;
    LAS float* tabL = (LAS float*)(lds + NST * STAGE);
    int tid_ = F.tid; asm volatile("" : "+v"(tid_));
    const int tid = tid_, w = F.wave, lane = tid & 63, qg = w >> 1, sel = w & 1, l31 = lane & 31, hh = lane >> 5;
    const int qrow = q0 + 32 * qg + l31, qmaxw = q0 + 32 * qg + 31;
    const int qcol = DIFF ? sel * 64 : 0, voff = DIFF ? 0 : sel * 128;
    __syncthreads();
    if (DIFF && tid < 129) tabL[tid] = tid ? tabg[tid - 1] : -INFINITY;
    constexpr bool QLDS = false;
    LAS unsigned char* qlds = lds + NST * STAGE + 1024 + w * 4096;
    bf16x8 qf[DQ / 16];
#pragma unroll
    for (int s = 0; s < DQ / 16; ++s) qf[s] = *(const bf16x8*)(Qb + (size_t)qrow * ldq + qcol + 16 * s + 8 * hh);
    if (QLDS) {
#pragma unroll
        for (int s = 0; s < DQ / 16; ++s) *(LAS bf16x8*)(qlds + (s * 64 + lane) * 16) = qf[s];
    }
    f32x16 O[4];
#pragma unroll
    for (int d = 0; d < 4; ++d)
#pragma unroll
        for (int i = 0; i < 16; ++i) O[d][i] = 0.f;
    float mrun = -INFINITY, lrun = 0.f;
    const int attmul = F.dry ? 0 : 1;
    u32x4 kreg[GL ? 1 : NK], vreg[GL ? 1 : NV];
    unsigned koff[NK], voffs[NV];
#pragma unroll
    for (int i_ = 0; i_ < NK; ++i_) { const int p_ = tid + 512 * i_, row_ = p_ / KPR, pc_ = p_ % KPR; koff[i_] = (unsigned)(row_ * ldk + pc_ * 8) * 2u; }
#pragma unroll
    for (int i_ = 0; i_ < NV; ++i_) { const int p_ = tid + 512 * i_, row_ = p_ >> 3, pc_ = p_ & 7; voffs[i_] = (unsigned)(row_ * 64 + pc_ * 8) * 2u; }
#define ATT_GLOAD(kt) do { const char* kb__ = (const char*)(Kb + (size_t)((kt) * attmul) * 64 * ldk); const char* vb__ = (const char*)(Vtb + (size_t)((kt) * attmul) * (NDV * 64)); \
        _Pragma("unroll") for (int i_ = 0; i_ < NK; ++i_) kreg[i_] = *(const __attribute__((address_space(1))) u32x4*)(const __attribute__((address_space(1))) char*)(kb__ + koff[i_]); \
        _Pragma("unroll") for (int i_ = 0; i_ < NV; ++i_) vreg[i_] = *(const __attribute__((address_space(1))) u32x4*)(const __attribute__((address_space(1))) char*)(vb__ + voffs[i_]); } while (0)
#define ATT_LSTORE(buf) do { LAS unsigned char* kb_ = lds + (buf) * STAGE; LAS unsigned char* vb_ = kb_ + KTILE; \
        _Pragma("unroll") for (int i_ = 0; i_ < NK; ++i_) { const int p_ = tid + 512 * i_, row_ = p_ / KPR, pc_ = p_ % KPR; *(LAS u32x4*)(kb_ + row_ * KROW + pc_ * 16) = kreg[i_]; } \
        _Pragma("unroll") for (int i_ = 0; i_ < NV; ++i_) { const int p_ = tid + 512 * i_, row_ = p_ >> 3, pc_ = p_ & 7; \
            *(LAS u32x2*)(vb_ + row_ * VROW + pc_ * 16) = (u32x2){vreg[i_].x, vreg[i_].y}; *(LAS u32x2*)(vb_ + row_ * VROW + pc_ * 16 + 8) = (u32x2){vreg[i_].z, vreg[i_].w}; } } while (0)
    unsigned gko[2], gvo[2];
#pragma unroll
    for (int i_ = 0; i_ < 2; ++i_) { const int kr = 4 * (2 * w + i_) + (lane >> 4); gko[i_] = (unsigned)kr * (unsigned)ldk * 2u + (unsigned)(((lane & 15) ^ (kr & 15)) << 4);
        const int vr = 8 * (2 * w + i_) + (lane >> 3); gvo[i_] = (unsigned)vr * 128u + (unsigned)(((lane & 7) ^ ((vr >> 1) & 7)) << 4); }
#define ATT_GLDS(t_, bufi_) do { const char* kb__ = (const char*)(Kb + (size_t)((t_) * attmul) * 64 * ldk); const char* vb__ = (const char*)(Vtb + (size_t)((t_) * attmul) * (NDV * 64)); \
        LAS unsigned char* sb__ = lds + (bufi_) * STAGE + w * 2048; \
        _Pragma("unroll") for (int i_ = 0; i_ < 2; ++i_) __builtin_amdgcn_global_load_lds((const unsigned*)(kb__ + gko[i_]), (LAS unsigned*)(sb__ + i_ * 1024), 16, 0, 0); \
        _Pragma("unroll") for (int i_ = 0; i_ < 2; ++i_) __builtin_amdgcn_global_load_lds((const unsigned*)(vb__ + gvo[i_]), (LAS unsigned*)(sb__ + KTILE + i_ * 1024), 16, 0, 0); } while (0)
    __syncthreads();
    const float c31 = DIFF ? tabL[128] : 0.f;
    if (GL) { ATT_GLDS(0, 0); if (nkt > 1) ATT_GLDS(1, 1); }
#define ATT_KADDR(Kt_, sub_, s_) (GL ? ((Kt_) + (32 * (sub_) + l31) * 256 + ((((qcol >> 3) + 2 * (s_) + hh) ^ ((32 * (sub_) + l31) & 15)) << 4)) : ((Kt_) + (32 * (sub_) + l31) * KROW + (qcol + 16 * (s_) + 8 * hh) * 2))
#define ATT_QKT(dst_, Kt_, sub_) do { _Pragma("unroll") for (int i = 0; i < 16; ++i) dst_[i] = 0.f; \
        _Pragma("unroll") for (int s = 0; s < DQ / 16; ++s) { const bf16x8 kf = *(const LAS bf16x8*)ATT_KADDR(Kt_, sub_, s); dst_ = __builtin_amdgcn_mfma_f32_32x32x16_bf16(kf, qf[s], dst_, 0, 0, 0); } } while (0)
#define ATT_VLD(Vt_, sub_, d_) do { _Pragma("unroll") for (int s = 0; s < 2; ++s) { const int vrow_ = voff + 32 * (d_) + l31; bf16x4 lo, hi; \
        if (GL) { const int q_ = 4 * (sub_) + 2 * s, f_ = (vrow_ >> 1) & 7; lo = *(const LAS bf16x4*)((Vt_) + vrow_ * 128 + ((q_ ^ f_) << 4) + 8 * hh); hi = *(const LAS bf16x4*)((Vt_) + vrow_ * 128 + (((q_ + 1) ^ f_) << 4) + 8 * hh); } \
        else { const LAS unsigned char* vp = (Vt_) + vrow_ * VROW + (32 * (sub_) + 16 * s + 4 * hh) * 2; lo = *(const LAS bf16x4*)vp; hi = *(const LAS bf16x4*)(vp + 16); } \
        vfr[d_][s] = __builtin_shufflevector(lo, hi, 0, 1, 2, 3, 4, 5, 6, 7); } } while (0)
#define ATT_SMPV(src_, ksub0_, Vt_, sub_) do { \
        bf16x8 vfr[4][2]; \
        ATT_VLD(Vt_, sub_, 0);     \
        float sv[16]; float tmax; \
        const bool nearp = DIFF && ((q0 + 32 * qg) - ((ksub0_) + 31) < 113); \
        if (nearp) {        \
            _Pragma("unroll") for (int i = 0; i < 16; ++i) { const int key = (ksub0_) + (i & 3) + 8 * (i >> 2) + 4 * hh; int idx = qrow - key + 1; idx = idx < 0 ? 0 : (idx > 128 ? 128 : idx); \
                sv[i] = src_[i] * scale2 + tabL[idx]; } \
            tmax = sv[0]; \
            _Pragma("unroll") for (int i = 1; i < 16; ++i) tmax = fmaxf(tmax, sv[i]); \
        } else {            \
            tmax = src_[0]; \
            _Pragma("unroll") for (int i = 1; i < 16; ++i) tmax = fmaxf(tmax, src_[i]); \
            tmax = tmax * scale2 + c31; \
        } \
        tmax = fmaxf(tmax, __shfl_xor(tmax, 32)); \
        const float mnew = fmaxf(mrun, tmax); \
        if (__any(mnew > mrun)) { \
            const float alpha = __builtin_amdgcn_exp2f(mrun - mnew); \
            _Pragma("unroll") for (int d = 0; d < 4; ++d) _Pragma("unroll") for (int i = 0; i < 16; ++i) O[d][i] *= alpha; \
            lrun *= alpha; mrun = mnew; \
        } \
        float ps = 0.f; float pv[16]; \
        if (nearp) { _Pragma("unroll") for (int i = 0; i < 16; ++i) { pv[i] = __builtin_amdgcn_exp2f(sv[i] - mrun); ps += pv[i]; } } \
        else { const float cm = c31 - mrun; _Pragma("unroll") for (int i = 0; i < 16; ++i) { pv[i] = __builtin_amdgcn_exp2f(src_[i] * scale2 + cm); ps += pv[i]; } } \
        lrun += ps; \
        bf16x8 pf[2]; \
        _Pragma("unroll") for (int s = 0; s < 2; ++s) { u32x4 pk; pk.x = pk2(pv[8 * s], pv[8 * s + 1]); pk.y = pk2(pv[8 * s + 2], pv[8 * s + 3]); pk.z = pk2(pv[8 * s + 4], pv[8 * s + 5]); pk.w = pk2(pv[8 * s + 6], pv[8 * s + 7]); pf[s] = __builtin_bit_cast(bf16x8, pk); } \
        ATT_VLD(Vt_, sub_, 1); ATT_VLD(Vt_, sub_, 2); ATT_VLD(Vt_, sub_, 3); \
        _Pragma("unroll") for (int d = 0; d < 4; ++d) _Pragma("unroll") for (int s = 0; s < 2; ++s) O[d] = __builtin_amdgcn_mfma_f32_32x32x16_bf16(vfr[d][s], pf[s], O[d], 0, 0, 0); \
        __builtin_amdgcn_sched_barrier(0); } while (0)
    const bool late = GL && (w >= 4);
    f32x16 sp; bool pend = false; const LAS unsigned char* pVt = lds; int pk0 = 0;
#pragma unroll
    for (int i = 0; i < 16; ++i) sp[i] = 0.f;
#pragma unroll 1
    for (int kt = 0; kt < nkt; ++kt) {
        const int buf = GL ? (kt & (NST - 1)) : 0, k0 = kt * 64;
        if (GL) {
            if (kt + 1 < nkt) asm volatile("s_waitcnt vmcnt(4)" ::: "memory"); else asm volatile("s_waitcnt vmcnt(0)" ::: "memory");
            __builtin_amdgcn_s_barrier();
            asm volatile("" ::: "memory");
            if (kt + 2 < nkt) ATT_GLDS(kt + 2, (kt + 2) & (NST - 1));
        } else { ATT_GLOAD(kt); ATT_LSTORE(0); __syncthreads(); }
        const LAS unsigned char* Kt = lds + buf * STAGE; const LAS unsigned char* Vt = Kt + KTILE;
        const bool act = !DIFF || k0 <= qmaxw;
        if (late && pend) { ATT_SMPV(sp, pk0, pVt, 1); pend = false; }
        if (act) {
            f32x16 sa; ATT_QKT(sa, Kt, 0); ATT_SMPV(sa, k0, Vt, 0);
            ATT_QKT(sp, Kt, 1); pend = true; pVt = Vt; pk0 = k0 + 32;
        }
        if (!late && pend) { ATT_SMPV(sp, pk0, pVt, 1); pend = false; }
        if (!GL) __syncthreads();
    }
    if (pend) { ATT_SMPV(sp, pk0, pVt, 1); }
    if (GL) { asm volatile("s_waitcnt vmcnt(0)" ::: "memory"); __syncthreads(); }
#undef ATT_GLOAD
#undef ATT_QKT
#undef ATT_SMPV
#undef ATT_VLD
#undef ATT_KADDR
#undef ATT_LSTORE
#undef ATT_GLDS
    lrun += __shfl_xor(lrun, 32);
    const float inv = 1.0f / lrun;
    if (F.dry) { __syncthreads(); return; }
    int q0e = q0; asm volatile("" : "+s"(q0e));
    const int qrow_e = q0e + 32 * qg + l31;
    if (DIFF) {
        LAS float* X = (LAS float*)lds;
        if (sel == 1) {
#pragma unroll
            for (int d = 0; d < 4; ++d)
#pragma unroll
                for (int i = 0; i < 16; ++i) X[(qg * 64 + d * 16 + i) * 64 + lane] = O[d][i] * inv;
        }
        __syncthreads();
        if (sel == 0) {
            const float lamv = *(const LAS float*)(lds + LDS_BAR - 16);
            float ss = 0.f;
#pragma unroll
            for (int d = 0; d < 4; ++d)
#pragma unroll
                for (int i = 0; i < 16; ++i) { const float v = O[d][i] * inv - lamv * X[(qg * 64 + d * 16 + i) * 64 + lane]; O[d][i] = v; ss += v * v; }
            ss += __shfl_xor(ss, 32);
            const float rn = (1.0f / sqrtf(ss * (1.f / 128.f) + EPS)) * 0.8f;
#pragma unroll
            for (int d = 0; d < 4; ++d)
#pragma unroll
                for (int g = 0; g < 4; ++g) { const int dv = 32 * d + 8 * g + 4 * hh; const f32x4 gn = *(const f32x4*)(gnorm + dv);
                    u32x2 ov; ov.x = pk2(O[d][4 * g] * rn * gn[0], O[d][4 * g + 1] * rn * gn[1]); ov.y = pk2(O[d][4 * g + 2] * rn * gn[2], O[d][4 * g + 3] * rn * gn[3]);
                    *(u32x2*)(Ob + (size_t)qrow_e * ldo + dv) = ov; }
        }
    } else {
#pragma unroll
        for (int d = 0; d < 4; ++d)
#pragma unroll
            for (int g = 0; g < 4; ++g) { const int dv = voff + 32 * d + 8 * g + 4 * hh;
                u32x2 ov; ov.x = pk2(O[d][4 * g] * inv, O[d][4 * g + 1] * inv); ov.y = pk2(O[d][4 * g + 2] * inv, O[d][4 * g + 3] * inv);
                *(u32x2*)(Ob + (size_t)qrow_e * ldo + dv) = ov; }
    }
}

enum Phase { PH_PRO = 0, PH_GU1, PH_DN1, PH_ROW2,
             PH_XM0, PH_CONV0  , PH_QPROJ0, PH_SPRE0, PH_SCAN0, PH_O0, PH_BM0  ,
             PH_CONV1, PH_QPROJ1, PH_SPRE1, PH_SCAN1, PH_O1, PH_BM1,
             PH_QKV, PH_ATT, PH_BAX, PH_WOUT, PH_ROW3, PH_GU2, PH_DN2, PH_FINAL, PH_COUNT };

__device__ __forceinline__ bool get_job(PRef P, const Frame& F, int ph, int j, pg8::Job& g) {
    using namespace pg8;
    bf16_t* H = WSP(bf16_t, WS_H); bf16_t* MG = WSP(bf16_t, WS_MERGED);
    bf16_t *SA = WSP(bf16_t, WS_A), *SB = WSP(bf16_t, WS_B), *SC = WSP(bf16_t, WS_C), *SD = WSP(bf16_t, WS_D);
    const bf16_t* WIN = WSP(bf16_t, WS_WIN);
    g = Job{}; g.lda = D; g.ldb = D; g.K = D; g.nM = 64; g.nN = 4; g.c = F.c; g.kind = E_NONE;
    int rot = 0;
    const int pair = (ph >= PH_CONV1 && ph <= PH_BM1) ? 1 : 0;
    switch (ph) {
    case PH_GU1: case PH_GU2:
        if (j == 0) { g.A = H; g.Bt = WSP(bf16_t, WS_WGU); g.nN = 22; g.kind = E_SWIGLU; g.o0 = WSP(bf16_t, WS_ACT); }
        else if (ph == PH_GU1 && j == 1) { g.A = WSP(bf16_t, WS_MEMN); g.Bt = WSP(bf16_t, WS_WMKV); g.nM = 4; g.kind = E_BF16; g.o0 = WSP(bf16_t, WS_KX); g.i0 = D; rot = 128; }
        else if (ph == PH_GU1 && j == 2) { g.A = WSP(bf16_t, WS_MEMN); g.Bt = WSP(bf16_t, WS_WMKV) + (size_t)1024 * D; g.nM = 4; g.kind = E_TRANS; g.o0 = WSP(bf16_t, WS_VXT); g.i0 = 8; g.i1 = 8; g.i2 = 6; g.s0 = 4 * 256 * 256; g.s1 = 256 * 256; rot = 112; }
        break;
    case PH_DN1: case PH_DN2:
        if (j == 0) { g.A = WSP(bf16_t, WS_ACT); g.lda = DFF; g.Bt = WSP(bf16_t, WS_WDN); g.ldb = DFF; g.K = DFF; g.kind = E_RESID; g.o0 = gp(P.out); g.p1 = (ph == PH_DN1) ? gp(P.x) : gp(P.out); g.f0 = 0.5f; }
        break;
    case PH_XM0:
        if (j == 0) { g.A = H; g.Bt = WIN; g.kind = E_BF16; g.o0 = SA; g.i0 = D; }
        break;
    case PH_CONV0: case PH_CONV1:
        if (j < 2) { g.A = SA + j * 512; g.Bt = WSP(bf16_t, WS_WVT) + (size_t)(pair * 2 + j) * 512 * 512; g.ldb = 512; g.K = 512; g.nN = 2; g.kind = E_TRANS; g.o0 = SB + (size_t)j * 512 * SEQ;
            g.i0 = 12; g.i1 = 9; g.i2 = 3; g.s0 = (long)2 * 512 * SEQ; g.s1 = 0; rot = j * 128; }
        break;
    case PH_QPROJ0: case PH_QPROJ1:
        if (j < 2) { g.A = SC + j * 512; g.Bt = WSP(bf16_t, WS_AT) + (size_t)(pair * 2 + j) * 512 * 512; g.ldb = 512; g.K = 512; g.nN = 2; g.kind = E_QPANEL; g.o0 = SA + (size_t)j * 512 * SEQ; g.s0 = (long)2 * 512 * SEQ; rot = j * 128; }
        break;
    case PH_O0: case PH_O1:
        if (j == 0) { g.A = H; g.Bt = WIN + (size_t)(2048 + pair * 1024) * D; g.kind = E_OGATE; g.o0 = SC; g.p1 = WSP(float, WS_SDEN); g.p2 = WSP(float, WS_LB); g.p3 = WSP(float, WS_SSQ); g.p4 = gp(P.m_head_norm); g.i0 = pair; }
        break;
    case PH_BM0:
        if (j == 0) { g.A = SC; g.Bt = WSP(bf16_t, WS_WBM); g.ldb = 2048; g.kind = E_MERGE0; g.o0 = MG; }
        else if (j == 1) { g.A = H; g.Bt = WIN + (size_t)1024 * D; g.kind = E_BF16; g.o0 = SA; g.i0 = D; }
        break;
    case PH_BM1:
        if (j == 0) { g.A = H; g.Bt = WIN + (size_t)8192 * D; g.kind = E_SIGB; g.o0 = SD; g.i0 = D; g.p1 = gp(P.b_gate); }
        else if (j == 1) { g.A = SC; g.Bt = WSP(bf16_t, WS_WBM) + 1024; g.ldb = 2048; g.kind = E_MERGE1; g.o0 = MG; g.p1 = SD; }
        break;
    case PH_QKV:
        if (j == 0) { g.A = H; g.Bt = WIN + (size_t)4096 * D; g.nN = 8; g.kind = E_BF16; g.o0 = SA; g.i0 = D; g.i1 = 4; g.s0 = (long)((WS_B - WS_A) / 2); }
        else if (j == 1) { g.A = H; g.Bt = WIN + (size_t)6144 * D; g.kind = E_TRANS; g.o0 = SC; g.i0 = 12; g.i1 = 7; g.i2 = 6; g.s0 = (long)8 * 128 * SEQ; g.s1 = (long)128 * SEQ; }
        else if (j == 2) { g.A = H; g.Bt = WIN + (size_t)7168 * D; g.kind = E_BF16; g.o0 = SD; g.i0 = D; }
        break;
    case PH_BAX:
        if (j == 0) { g.A = H; g.Bt = WIN + (size_t)(8192 + 1024) * D; g.kind = E_SIGB; g.o0 = SB; g.i0 = D; g.p1 = gp(P.b_gate) + 1024; }
        else if (j == 1) { g.A = SA; g.Bt = WSP(bf16_t, WS_WBA); g.kind = E_MERGE2; g.o0 = MG; g.p1 = SB; }
        else if (j == 2) { g.A = H; g.Bt = WIN + (size_t)(8192 + 2048) * D; g.kind = E_SIGB; g.o0 = SC; g.i0 = D; g.p1 = gp(P.b_gate) + 2048; }
        else if (j == 3) { g.A = SD; g.Bt = WSP(bf16_t, WS_WBX); g.kind = E_MERGE2; g.o0 = MG; g.p1 = SC; }
        break;
    case PH_WOUT:
        if (j == 0) { g.A = MG; g.Bt = WSP(bf16_t, WS_WOUT); g.kind = E_RESID; g.o0 = gp(P.out); g.p1 = gp(P.out); g.f0 = 1.0f; }
        break;
    default: break;
    }
    g.c = (F.c + rot) % F.G; g.dry = F.dry;
    return g.kind != E_NONE;
}

__device__ __forceinline__ void run_phase(const Frame& F0, int ph) {
    const __attribute__((address_space(4))) ParamsG* kp_ = (const __attribute__((address_space(4))) ParamsG*)__builtin_amdgcn_kernarg_segment_ptr();
    asm volatile("" : "+s"(kp_));
    PRef P = *kp_;
    Frame F = F0;
    { int w_ = F.wave, c_ = F.c; asm volatile("" : "+s"(w_)); asm volatile("" : "+s"(c_));
      int l_ = (int)__builtin_amdgcn_mbcnt_hi(~0u, __builtin_amdgcn_mbcnt_lo(~0u, 0u)); asm volatile("" : "+v"(l_));
      F.tid = w_ * 64 + l_; F.lane = l_; F.wave = w_; F.c = c_;
      GAS unsigned char* ws_ = F.ws; asm volatile("" : "+s"(ws_)); F.ws = ws_; int g_ = F.G; asm volatile("" : "+s"(g_)); F.G = g_; }
    const int pair = (ph >= PH_CONV1 && ph <= PH_BM1) ? 1 : 0;
    switch (ph) {
    case PH_PRO: {
        convert_jobs(P, F, 0, 12);
        rowpass_bf16(F, gp(P.x), gp(P.ffn1_norm), WSP(bf16_t, WS_H), T);
        rowpass_bf16(F, gp(P.mem), gp(P.mem_norm), WSP(bf16_t, WS_MEMN), NB * MEML);
        if (F.c == F.G - 1) bias_table(P, F);
        __syncthreads();
        for (int u = F.c; u < 256; u += F.G) at_unit(P, F, u);
    } break;
    case PH_ROW2: row2_phase(P, F); break;
    case PH_GU2: if (F.c >= F.G / 2) { Frame F2 = F; F2.c = F.c - F.G / 2; F2.G = F.G - F.G / 2; convert_jobs(P, F2, 13, 14); } break;
    case PH_XM0: for (int u = F.c; u < 16; u += F.G) gscan_unit(P, F, u); break;
    case PH_CONV0: case PH_CONV1: for (int u = F.c; u < 2048; u += F.G) conv_unit(P, F, pair, u); break;
    case PH_SPRE0: case PH_SPRE1: for (int u = F.c; u < 256; u += F.G) spre_unit(P, F, pair, u); break;
    case PH_SCAN0: case PH_SCAN1: for (int u = F.c; u < 8 * SCAN_NE; u += F.G) scan_unit<SCAN_NT>(P, F, pair, u); break;
    case PH_ATT: {
        float lam;
        { float s1 = 0.f, s2 = 0.f; for (int i = 0; i < 64; ++i) { s1 += gp(P.a_lam_q1)[i] * gp(P.a_lam_k1)[i]; s2 += gp(P.a_lam_q2)[i] * gp(P.a_lam_k2)[i]; } lam = expf(s1) - expf(s2) + 0.2f; }
        if (F.tid == 0) *(LAS float*)(F.lds + LDS_BAR - 16) = lam;
        lam = 0.f;
        bf16_t *SA = WSP(bf16_t, WS_A), *SB = WSP(bf16_t, WS_B), *SC = WSP(bf16_t, WS_C), *SD = WSP(bf16_t, WS_D);
#pragma unroll 1
        for (int u = F.c; u < 512; u += F.G) {
            const int xcd = u & 7, idx = u >> 3, bh = xcd * 4 + (idx >> 4), j = idx & 15, b = bh >> 3, h = bh & 7;
            const bf16_t* Qb = SA + (size_t)b * SEQ * D + h * 128; const bf16_t* Kb = SB + (size_t)b * SEQ * D + h * 128; const bf16_t* Vtb = SC + (size_t)(b * 8 + h) * 128 * SEQ;
#pragma unroll 1
            for (int side = 0; side < 2; ++side) { const int qb = side ? 31 - j : j;
                attn_block<64, 128, true>(F, Qb, D, Kb, D, Vtb, SEQ, (bf16_t*)Qb, D, qb * 128, 2 * qb + 2, 0.125f * LOG2E, WSP(float, WS_TAB) + h * 128, lam, gp(P.a_head_norm) + h * 128); }
        }
#pragma unroll 1
        for (int u = F.c; u < 512; u += F.G) {
            const int xcd = u & 7, idx = u >> 3, bh = xcd * 2 + (idx >> 5), qb = idx & 31, b = bh >> 2, h = bh & 3;
            const bf16_t* Qb = SD + (size_t)b * SEQ * D + h * 256; const bf16_t* Kb = WSP(bf16_t, WS_KX) + (size_t)b * MEML * D + h * 256; const bf16_t* Vtb = WSP(bf16_t, WS_VXT) + (size_t)(b * 4 + h) * 256 * 256;
            attn_block<256, 256, false>(F, Qb, D, Kb, D, Vtb, 256, (bf16_t*)Qb, D, qb * 128, 4, 0.0625f * LOG2E, nullptr, 0.f, nullptr);
        }
    } break;
    case PH_ROW3: rowpass_bf16(F, gp(P.out), gp(P.ffn2_norm), WSP(bf16_t, WS_H), T); break;
    case PH_FINAL: {
        const int lane = F.lane, stride = F.G * 8; float* OUT = gp(P.out);
        f32x4 gv[4];
#pragma unroll
        for (int j = 0; j < 4; ++j) gv[j] = ((const f32x4*)gp(P.final_norm))[lane + 64 * j];
        for (int r0 = F.c * 8 + F.wave; r0 < T; r0 += 4 * stride) {
            f32x4 v[4][4];
#pragma unroll
            for (int q = 0; q < 4; ++q) { const int r = r0 + q * stride;
#pragma unroll
                for (int j = 0; j < 4; ++j) v[q][j] = (r < T) ? ((const f32x4*)(OUT + (size_t)r * D))[lane + 64 * j] : (f32x4){0.f, 0.f, 0.f, 0.f}; }
#pragma unroll
            for (int q = 0; q < 4; ++q) { const int r = r0 + q * stride; float s = 0.f;
#pragma unroll
                for (int j = 0; j < 4; ++j) s += (v[q][j][0] * v[q][j][0] + v[q][j][1] * v[q][j][1]) + (v[q][j][2] * v[q][j][2] + v[q][j][3] * v[q][j][3]);
                const float rr = 1.0f / sqrtf(wave_sum(s) * (1.f / D) + EPS);
                if (r < T && !F.dry) {
#pragma unroll
                    for (int j = 0; j < 4; ++j) ((f32x4*)(OUT + (size_t)r * D))[lane + 64 * j] = v[q][j] * rr * gv[j]; } }
        }
    } break;
    default: break;
    }
    __syncthreads();
#pragma unroll 1
    for (int j = 0; j < 4; ++j) { pg8::Job g; if (!get_job(P, F, ph, j, g)) break;
        auto jobfn = [&](pg8::Job& ge) { int ph_ = ph, j_ = j; asm volatile("" : "+s"(ph_), "+s"(j_)); (void)get_job(P, F, ph_, j_, ge); };
        if (g.kind == pg8::E_TRANS) pg8::gemm_run<true>(F.lds, g, F.G, F.tid, jobfn); else pg8::gemm_run<false>(F.lds, g, F.G, F.tid, jobfn); }
    if (ph == PH_WOUT) convert_jobs(P, F, 12, 13);
}

extern "C" __global__ void __launch_bounds__(512, 2) mega_fwd(Params P) {
    extern __shared__ __attribute__((aligned(16))) unsigned char smem[];
    Frame F; F.lds = (LAS unsigned char*)smem; F.ws = (GAS unsigned char*)P.ws; F.tid = threadIdx.x; F.lane = threadIdx.x & 63; F.wave = __builtin_amdgcn_readfirstlane(threadIdx.x >> 6);
    F.c = blockIdx.x; F.G = gridDim.x; F.dry = 0;
#if N_LAUNCH_MODE == 1
    volatile LAS unsigned* st = (volatile LAS unsigned*)(F.lds + LDS_BAR);
    if (threadIdx.x == 0) { st[0] = 0u; st[1] = 0u; }
    __syncthreads();
    XcdBarrier bar = xcd_barrier_post((unsigned*)((GAS unsigned char*)P.ws + WS_CTL), st);
#endif
#ifdef ONLY_PHASE
    run_phase(F, ONLY_PHASE);
#endif
    int rep = 0;
    for (int ph = P.ph_lo; ph < P.ph_hi;) {
        const int extra = (int)((REP_MASK >> ph) & 1ull) * REP_N;
        F.dry = (rep < extra) ? (int)((DRY_MASK >> ph) & 1ull) : 0;
#ifndef ONLY_PHASE
        run_phase(F, ph);
#endif
        if (rep < extra) ++rep; else { rep = 0; ++ph; }
#if N_LAUNCH_MODE == 1
        if (ph < P.ph_hi) { int w_ = F.wave; asm volatile("" : "+s"(w_)); int l_ = (int)__builtin_amdgcn_mbcnt_hi(~0u, __builtin_amdgcn_mbcnt_lo(~0u, 0u)); asm volatile("" : "+v"(l_)); xcd_barrier(bar, w_ == 0 && l_ == 0); }
#endif
    }
}

extern "C" void kernel_launch(void* const* d_in, const int* in_sizes, int n_in, void* d_out, int out_size, void* d_ws, size_t ws_size, hipStream_t stream) {
    static int grid = 0;
    if (grid == 0) {
        if (n_in != 32 || in_sizes[0] != T * D || out_size != T * D || ws_size < WS_END) { fprintf(stderr, "kernel_launch: unexpected shapes (n_in %d, in0 %d, out %d, ws %zu); nothing launched\n", n_in, n_in > 0 ? in_sizes[0] : -1, out_size, ws_size); grid = -1; return; }
        int dev = 0, cus = 0;
        if (hipGetDevice(&dev) != hipSuccess || hipDeviceGetAttribute(&cus, hipDeviceAttributeMultiprocessorCount, dev) != hipSuccess) { grid = -1; return; }
        if (hipFuncSetAttribute((const void*)mega_fwd, hipFuncAttributeMaxDynamicSharedMemorySize, LDS_BYTES) != hipSuccess) { fprintf(stderr, "kernel_launch: hipFuncSetAttribute failed\n"); grid = -1; return; }
        int per_cu = 0;
        if (hipOccupancyMaxActiveBlocksPerMultiprocessor(&per_cu, (const void*)mega_fwd, 512, LDS_BYTES) != hipSuccess || per_cu < 1) fprintf(stderr, "kernel_launch: occupancy query reports %d blocks per CU\n", per_cu);
        (void)hipGetLastError();
        grid = cus;
    }
    if (grid < 0) return;
    Params p{};
    const float** fp = (const float**)&p.x;
    (void)fp;
    p.x = (const float*)d_in[0]; p.mem = (const float*)d_in[1]; p.positions = (const int*)d_in[2]; p.rel_bias = (const float*)d_in[3];
    p.ffn1_norm = (const float*)d_in[4]; p.ffn1_w_gu = (const float*)d_in[5]; p.ffn1_w_down = (const float*)d_in[6]; p.mix_norm = (const float*)d_in[7]; p.mem_norm = (const float*)d_in[8];
    p.w_in = (const float*)d_in[9]; p.b_if = (const float*)d_in[10]; p.b_gate = (const float*)d_in[11]; p.m_conv_w = (const float*)d_in[12]; p.m_conv_b = (const float*)d_in[13];
    p.m_wq = (const float*)d_in[14]; p.m_wk = (const float*)d_in[15]; p.m_wv = (const float*)d_in[16]; p.m_head_norm = (const float*)d_in[17];
    p.a_lam_q1 = (const float*)d_in[18]; p.a_lam_k1 = (const float*)d_in[19]; p.a_lam_q2 = (const float*)d_in[20]; p.a_lam_k2 = (const float*)d_in[21]; p.a_head_norm = (const float*)d_in[22];
    p.w_mem_kv = (const float*)d_in[23]; p.w_branch_m = (const float*)d_in[24]; p.w_branch_a = (const float*)d_in[25]; p.w_branch_x = (const float*)d_in[26]; p.w_out = (const float*)d_in[27];
    p.ffn2_norm = (const float*)d_in[28]; p.ffn2_w_gu = (const float*)d_in[29]; p.ffn2_w_down = (const float*)d_in[30]; p.final_norm = (const float*)d_in[31];
    p.out = (float*)d_out; p.ws = (unsigned char*)d_ws;
#if N_LAUNCH_MODE == 1
    if (hipMemsetAsync((char*)d_ws + WS_CTL, 0, CTL_BYTES, stream) != hipSuccess) { fprintf(stderr, "kernel_launch: memset failed\n"); return; }
    p.ph_lo = 0; p.ph_hi = PH_COUNT;
    hipLaunchKernelGGL(mega_fwd, dim3(grid), dim3(512), LDS_BYTES, stream, p);
#else
    for (int ph = 0; ph < PH_COUNT; ++ph) { p.ph_lo = ph; p.ph_hi = ph + 1; hipLaunchKernelGGL(mega_fwd, dim3(grid), dim3(512), LDS_BYTES, stream, p); }
#endif
    const hipError_t le = hipPeekAtLastError();
    if (le != hipSuccess) fprintf(stderr, "kernel_launch: launch failed: %s\n", hipGetErrorName(le));
}
```

```cpp
#include <hip/hip_runtime.h>
#include <cstdio>
#include <cstdint>

#define LAS __attribute__((address_space(3)))
typedef unsigned short bf16_t;
typedef short bf16x8 __attribute__((ext_vector_type(8)));
typedef short bf16x4 __attribute__((ext_vector_type(4)));
typedef float f32x2 __attribute__((ext_vector_type(2)));
typedef float f32x4 __attribute__((ext_vector_type(4)));
typedef float f32x16 __attribute__((ext_vector_type(16)));
typedef unsigned u32x2 __attribute__((ext_vector_type(2)));
typedef unsigned u32x4 __attribute__((ext_vector_type(4)));
typedef __bf16 bf2_t __attribute__((ext_vector_type(2)));

#ifndef REP_MASK
#define REP_MASK 0ull
#endif
#ifndef DRYMODE
#define DRYMODE 0
#endif
#ifndef DRY_EXTRA
#define DRY_EXTRA 0ull
#endif
#define DRY_MASK (DRY_EXTRA | (1ull << PH_O0) | (1ull << PH_O1) | (1ull << PH_BM1) | (1ull << PH_ATT) | (1ull << PH_BAX) | (1ull << PH_WOUT) | (1ull << PH_DN2) | (1ull << PH_FINAL))
#ifndef REP_N
#define REP_N 1
#endif
#ifndef N_LAUNCH_MODE
#define N_LAUNCH_MODE 1
#endif

constexpr int T = 16384, D = 1024, SEQ = 4096, NB = 4, DFF = 2816, MEML = 256;
constexpr float EPS = 1e-6f;
constexpr float LOG2E = 1.4426950408889634f;

constexpr size_t MiB = 1u << 20;
constexpr size_t WS_CTL = 0, CTL_BYTES = 64 * 1024;
constexpr size_t WS_GATES = 1 * MiB;
constexpr size_t WS_AS = WS_GATES + 512 * 1024;
constexpr size_t WS_MT = WS_AS + 256 * 1024;
constexpr size_t WS_WI = WS_MT + 256 * 1024;
constexpr size_t WS_LB = WS_WI + 256 * 1024;
constexpr size_t WS_WS = WS_LB + 256 * 1024;
constexpr size_t WS_SDEN = WS_WS + 256 * 1024;
constexpr size_t WS_DEN = WS_SDEN + 256 * 1024;
constexpr size_t WS_DEC = WS_DEN + 256 * 1024;
constexpr size_t WS_TAB = WS_DEC + 4096;
constexpr size_t WS_SSQ = 4 * MiB;
constexpr size_t WS_MEMN = 8 * MiB;
constexpr size_t WS_KX = 10 * MiB;
constexpr size_t WS_VXT = 12 * MiB;
constexpr size_t WS_DENP = 14 * MiB;
constexpr size_t WS_W = 16 * MiB;
constexpr size_t WS_WIN = WS_W;
constexpr size_t WS_AT = WS_WIN + 22 * MiB;
constexpr size_t WS_WVT = WS_AT + 2 * MiB;
constexpr size_t WS_WMKV = WS_WVT + 2 * MiB;
constexpr size_t WS_WBM = WS_WMKV + 4 * MiB;
constexpr size_t WS_WBA = WS_WBM + 4 * MiB;
constexpr size_t WS_WBX = WS_WBA + 2 * MiB;
constexpr size_t WS_WOUT = WS_WBX + 2 * MiB;
constexpr size_t WS_H = 56 * MiB;
constexpr size_t WS_MERGED = 88 * MiB;
constexpr size_t WS_A = 120 * MiB, WS_B = 152 * MiB, WS_C = 184 * MiB, WS_D = 216 * MiB;
constexpr size_t WS_S = 248 * MiB;
constexpr size_t WS_ACT = WS_A;
constexpr size_t WS_WGU = 208 * MiB;
constexpr size_t WS_WDN = 219 * MiB;
constexpr size_t WS_END = 256 * MiB;

constexpr int SCAN_PARTS = 32;
constexpr int LDS_BYTES = 153600;
constexpr int LDS_BAR = 153600 - 64;

__device__ __forceinline__ unsigned pk2(float lo, float hi) { f32x2 v = {lo, hi}; bf2_t b = __builtin_convertvector(v, bf2_t); return __builtin_bit_cast(unsigned, b); }
__device__ __forceinline__ float bflo(unsigned u) { return __uint_as_float(u << 16); }
__device__ __forceinline__ float bfhi(unsigned u) { return __uint_as_float(u & 0xffff0000u); }
template <int CTRL> __device__ __forceinline__ float dpp_mov(float v) { return __int_as_float(__builtin_amdgcn_update_dpp(0, __float_as_int(v), CTRL, 0xF, 0xF, true)); }
__device__ __forceinline__ float wave_sum(float v) {
    v += dpp_mov<0xB1>(v); v += dpp_mov<0x4E>(v); v += dpp_mov<0x141>(v); v += dpp_mov<0x140>(v);
    const int iv = __float_as_int(v);
    return (__int_as_float(__builtin_amdgcn_readlane(iv, 0)) + __int_as_float(__builtin_amdgcn_readlane(iv, 16))) + (__int_as_float(__builtin_amdgcn_readlane(iv, 32)) + __int_as_float(__builtin_amdgcn_readlane(iv, 48)));
}
template <int Dn> __device__ __forceinline__ float row_shr(float v, float fill) {
    return __int_as_float(__builtin_amdgcn_update_dpp(__float_as_int(fill), __float_as_int(v), 0x110 + Dn, 0xF, 0xF, false));
}
__device__ __forceinline__ float fast_rcp(float x) { return __builtin_amdgcn_rcpf(x); }
__device__ __forceinline__ float sigmoidf_(float x) { return fast_rcp(1.f + __expf(-x)); }

struct Params {
    const float *x, *mem; const int* positions;
    const float *rel_bias, *ffn1_norm, *ffn1_w_gu, *ffn1_w_down, *mix_norm, *mem_norm, *w_in, *b_if, *b_gate, *m_conv_w, *m_conv_b,
        *m_wq, *m_wk, *m_wv, *m_head_norm, *a_lam_q1, *a_lam_k1, *a_lam_q2, *a_lam_k2, *a_head_norm, *w_mem_kv, *w_branch_m, *w_branch_a,
        *w_branch_x, *w_out, *ffn2_norm, *ffn2_w_gu, *ffn2_w_down, *final_norm;
    float* out; unsigned char* ws;
    int ph_lo, ph_hi;
};

#define GAS __attribute__((address_space(1)))
struct ParamsG {
    GAS const float *x, *mem; GAS const int* positions;
    GAS const float *rel_bias, *ffn1_norm, *ffn1_w_gu, *ffn1_w_down, *mix_norm, *mem_norm, *w_in, *b_if, *b_gate, *m_conv_w, *m_conv_b,
        *m_wq, *m_wk, *m_wv, *m_head_norm, *a_lam_q1, *a_lam_k1, *a_lam_q2, *a_lam_k2, *a_head_norm, *w_mem_kv, *w_branch_m, *w_branch_a,
        *w_branch_x, *w_out, *ffn2_norm, *ffn2_w_gu, *ffn2_w_down, *final_norm;
    GAS float* out; GAS unsigned char* ws;
    int ph_lo, ph_hi;
};
static_assert(sizeof(ParamsG) == sizeof(Params), "ParamsG mirrors Params");
template <class T> __device__ __forceinline__ T* gp(GAS T* p) { return (T*)p; }
typedef const __attribute__((address_space(4))) ParamsG& PRef;

namespace pg8 {
constexpr int BM = 256, BK = 64, HALF = 128, HTB = HALF * BK * 2, STAGE_BYTES = 8 * HTB, NXCD = 8, WGM = 8;
__host__ __device__ __forceinline__ int lds_byte(int r, int c) { const int st = (r >> 4) * 2 + (c >> 5), rr = r & 15, cc = c & 31, ob = rr * 64 + cc * 2; return st * 1024 + (ob ^ (((ob >> 9) & 1) << 5)); }
__host__ __device__ __forceinline__ void stage_rc(int b, int& R, int& C) { const int st = b / 1024, sb = b % 1024, swz = sb ^ (((sb >> 9) & 1) << 5); R = (st >> 1) * 16 + swz / 64; C = (st & 1) * 32 + (swz % 64) / 2; }
__host__ __device__ __forceinline__ int perm32(int rho) { const int n = rho >> 4, i = rho & 15; return 8 * (i >> 2) + 4 * n + (i & 3); }

struct Unit { int pm, pn; };
enum EpiKind { E_NONE = 0, E_SWIGLU, E_RESID, E_BF16, E_SIGB, E_TRANS, E_OGATE, E_MERGE0, E_MERGE1, E_MERGE2, E_QPANEL };
struct Job {
    const bf16_t* A; const bf16_t* Bt; int lda, ldb, K, nM, nN, c;
    int kind;
    void* o0; const void* p1; const void* p2; const void* p3; const void* p4;
    int i0, i1, i2; long s0, s1; float f0; int dry;
};
typedef f32x4 Acc[2][2][4][2];
__device__ __forceinline__ bool next_unit(const Job& g, int G, int i, Unit& u) {
    const long L = (long)i * G + g.c; const int nwg = g.nM * g.nN;
    if (L >= (long)nwg) return false;
    int wgid = (int)L;
    { const int q = nwg / NXCD, r = nwg % NXCD, xcd = wgid % NXCD, off = wgid / NXCD; wgid = (xcd < r ? xcd * (q + 1) : r * (q + 1) + (xcd - r) * q) + off; }
    const int nig = WGM * g.nN, gid = wgid / nig, fm = gid * WGM, gsz = (g.nM - fm) < WGM ? (g.nM - fm) : WGM;
    u.pm = fm + ((wgid % nig) % gsz); u.pn = (wgid % nig) / gsz; return true;
}
__device__ __forceinline__ void unpack8(const u32x4 v, float (&o)[8]) { o[0] = bflo(v.x); o[1] = bfhi(v.x); o[2] = bflo(v.y); o[3] = bfhi(v.y); o[4] = bflo(v.z); o[5] = bfhi(v.z); o[6] = bflo(v.w); o[7] = bfhi(v.w); }
__device__ __forceinline__ u32x4 pack8(const float (&o)[8]) { u32x4 w; w.x = pk2(o[0], o[1]); w.y = pk2(o[2], o[3]); w.z = pk2(o[4], o[5]); w.w = pk2(o[6], o[7]); return w; }

template <bool SWAP>
__device__ __forceinline__ void epilogue(const Job& g, const Acc& acc, const Unit& u, int wr, int wc, int fr, int fq) {
    if (g.dry) return;
    if (SWAP) {
        bf16_t* O = (bf16_t*)g.o0; const int rb = g.i0, cg = g.i1, bs = g.i2; const int rbmask = (1 << rb) - 1, cgmask = (1 << cg) - 1, bmask = (1 << bs) - 1;
#pragma unroll
        for (int ai = 0; ai < 2; ++ai)
#pragma unroll
            for (int m = 0; m < 4; ++m) { const int r = u.pm * BM + ai * HALF + wr * 64 + m * 16 + 4 * fq;
#pragma unroll
                for (int bj = 0; bj < 2; ++bj)
#pragma unroll
                    for (int n = 0; n < 2; ++n) { const int c = u.pn * BM + bj * HALF + wc * 32 + perm32(16 * n + fr); const f32x4 v = acc[ai][bj][m][n];
                        u32x2 w; w.x = pk2(v[0], v[1]); w.y = pk2(v[2], v[3]);
                        *(u32x2*)(O + (size_t)(r >> rb) * g.s0 + (size_t)(c >> cg) * g.s1 + ((size_t)((r & rbmask) >> bs) << (cg + bs)) + ((size_t)(c & cgmask) << bs) + (r & bmask)) = w; } }
        return;
    }
    const int row0 = u.pm * BM + wr * 64 + fr;
    const int cw = wc * 32 + 8 * fq;
    switch (g.kind) {
    case E_SWIGLU: {
        bf16_t* O = (bf16_t*)g.o0;
#pragma unroll
        for (int ai = 0; ai < 2; ++ai)
#pragma unroll
            for (int m = 0; m < 4; ++m) { float v[8];
#pragma unroll
                for (int n = 0; n < 2; ++n)
#pragma unroll
                    for (int j = 0; j < 4; ++j) { const float gt = acc[ai][0][m][n][j], up = acc[ai][1][m][n][j]; v[n * 4 + j] = gt * sigmoidf_(gt) * up; }
                *(u32x4*)(O + (size_t)(row0 + ai * HALF + m * 16) * DFF + u.pn * HALF + cw) = pack8(v); }
    } break;
    case E_RESID: {
        const float* base = (const float*)g.p1; float* out = (float*)g.o0; const float alpha = g.f0;
#pragma unroll
        for (int ai = 0; ai < 2; ++ai)
#pragma unroll
            for (int m = 0; m < 4; ++m) { const size_t off = (size_t)(row0 + ai * HALF + m * 16) * D + u.pn * BM + cw;
#pragma unroll
                for (int bj = 0; bj < 2; ++bj)
#pragma unroll
                    for (int n = 0; n < 2; ++n) { const f32x4 bs = *(const f32x4*)(base + off + bj * HALF + n * 4); *(f32x4*)(out + off + bj * HALF + n * 4) = bs + alpha * acc[ai][bj][m][n]; } }
    } break;
    case E_BF16: case E_SIGB: {
        bf16_t* base = (bf16_t*)g.o0; const int ldc = g.i0; int pn = u.pn;
        if (g.i1) { const int t = pn / g.i1; base += (size_t)t * g.s0; pn -= t * g.i1; }
        const float* bias = (const float*)g.p1;
#pragma unroll
        for (int ai = 0; ai < 2; ++ai)
#pragma unroll
            for (int m = 0; m < 4; ++m) { bf16_t* rowp = base + (size_t)(row0 + ai * HALF + m * 16) * ldc + pn * BM + cw;
#pragma unroll
                for (int bj = 0; bj < 2; ++bj) { float v[8];
#pragma unroll
                    for (int j = 0; j < 4; ++j) { v[j] = acc[ai][bj][m][0][j]; v[4 + j] = acc[ai][bj][m][1][j]; }
                    if (g.kind == E_SIGB) { const f32x4 b0 = *(const f32x4*)(bias + u.pn * BM + cw + bj * HALF), b1 = *(const f32x4*)(bias + u.pn * BM + cw + bj * HALF + 4);
#pragma unroll
                        for (int j = 0; j < 4; ++j) { v[j] = sigmoidf_(v[j] + b0[j]); v[4 + j] = sigmoidf_(v[4 + j] + b1[j]); } }
                    *(u32x4*)(rowp + bj * HALF) = pack8(v); } }
    } break;
    case E_QPANEL: {
        bf16_t* O = (bf16_t*)g.o0;
#pragma unroll
        for (int ai = 0; ai < 2; ++ai)
#pragma unroll
            for (int m = 0; m < 4; ++m) { const int t = row0 + ai * HALF + m * 16;
#pragma unroll
                for (int bj = 0; bj < 2; ++bj) { float v[8];
#pragma unroll
                    for (int j = 0; j < 4; ++j) { v[j] = acc[ai][bj][m][0][j]; v[4 + j] = acc[ai][bj][m][1][j]; }
                    const int dg = (u.pn * BM + bj * HALF + cw) >> 3;
                    *(u32x4*)(O + (size_t)(t >> 12) * g.s0 + ((size_t)dg * SEQ + (t & 4095)) * 8) = pack8(v); } }
    } break;
    case E_OGATE: {
        bf16_t* NUM = (bf16_t*)g.o0; const float *SDENv = (const float*)g.p1, *LBv = (const float*)g.p2, *SSQ = (const float*)g.p3, *gnorm = (const float*)g.p4; const int pair = g.i0;
        const bf16_t* DENP = (const bf16_t*)((const unsigned char*)SSQ + (WS_DENP - WS_SSQ));
        const int hz = u.pn >> 1, hg = pair * 2 + hz;
#pragma unroll
        for (int ai = 0; ai < 2; ++ai)
#pragma unroll
            for (int m = 0; m < 4; ++m) { const int t = row0 + ai * HALF + m * 16;
                const f32x4* sp = (const f32x4*)(SSQ + ((size_t)t * 2 + hz) * 32); float ss = 0.f;
#pragma unroll
                for (int q = 0; q < SCAN_PARTS / 4; ++q) { const f32x4 s4 = sp[q]; ss += (s4[0] + s4[1]) + (s4[2] + s4[3]); }
                float den = SDENv[(size_t)t * 4 + hg]; const float lb = LBv[(size_t)t * 4 + hg];
                { const u32x4* dpp = (const u32x4*)(DENP + ((size_t)t * 2 + hz) * 32);
#pragma unroll
                  for (int q = 0; q < SCAN_PARTS / 8; ++q) { float dv[8]; unpack8(dpp[q], dv); den += ((dv[0] + dv[1]) + (dv[2] + dv[3])) + ((dv[4] + dv[5]) + (dv[6] + dv[7])); } }
                const float inv = 1.0f / fmaxf(fabsf(den), lb);
                const float sc = inv * (1.0f / sqrtf(inv * inv * ss * (1.0f / 512.f) + EPS));
                bf16_t* rowp = NUM + (size_t)t * D + u.pn * BM + cw;
#pragma unroll
                for (int bj = 0; bj < 2; ++bj) { float nv[8], o[8]; unpack8(*(const u32x4*)(rowp + bj * HALF), nv);
                    const f32x4 g0 = *(const f32x4*)(gnorm + pair * 1024 + u.pn * BM + cw + bj * HALF), g1 = *(const f32x4*)(gnorm + pair * 1024 + u.pn * BM + cw + bj * HALF + 4);
#pragma unroll
                    for (int j = 0; j < 4; ++j) { o[j] = sigmoidf_(acc[ai][bj][m][0][j]) * nv[j] * sc * g0[j]; o[4 + j] = sigmoidf_(acc[ai][bj][m][1][j]) * nv[4 + j] * sc * g1[j]; }
                    *(u32x4*)(rowp + bj * HALF) = pack8(o); } }
    } break;
    case E_MERGE0: case E_MERGE1: case E_MERGE2: {
        bf16_t* Mg = (bf16_t*)g.o0; const bf16_t* G = (const bf16_t*)g.p1;
#pragma unroll
        for (int ai = 0; ai < 2; ++ai)
#pragma unroll
            for (int m = 0; m < 4; ++m) { const size_t off = (size_t)(row0 + ai * HALF + m * 16) * D + u.pn * BM + cw;
#pragma unroll
                for (int bj = 0; bj < 2; ++bj) { float o[8];
#pragma unroll
                    for (int j = 0; j < 4; ++j) { o[j] = acc[ai][bj][m][0][j]; o[4 + j] = acc[ai][bj][m][1][j]; }
                    if (g.kind != E_MERGE0) { float mo[8], go[8]; unpack8(*(const u32x4*)(Mg + off + bj * HALF), mo); unpack8(*(const u32x4*)(G + off + bj * HALF), go);
#pragma unroll
                        for (int j = 0; j < 8; ++j) o[j] = (g.kind == E_MERGE1) ? go[j] * (mo[j] + o[j]) : mo[j] + go[j] * o[j]; }
                    *(u32x4*)(Mg + off + bj * HALF) = pack8(o); } }
    } break;
    default: break;
    }
}

template <bool SWAP, class JobFn>
__device__ __forceinline__ void gemm_run(LAS unsigned char* lds, const Job& g, const int G, const int tid, const JobFn& jobfn) {
    const int wid = __builtin_amdgcn_readfirstlane(tid >> 6), lane = tid & 63, wr = wid >> 2, wc = wid & 3, fr = lane & 15, fq = lane >> 4;
    const int K = g.K, nt = K / BK;
    unsigned voffA[2], voffB[2];
#pragma unroll
    for (int i = 0; i < 2; ++i) { int R, C; stage_rc(tid * 16 + i * 8192, R, C); const int Rb = (R & ~31) + perm32(R & 31);
        voffA[i] = (unsigned)(R * g.lda + C) * 2u; voffB[i] = (unsigned)(Rb * g.ldb + C) * 2u; }
    const size_t kstep = (size_t)(BK * 2);
    const size_t hstepA = (size_t)HALF * g.lda * 2, hstepB = (size_t)HALF * g.ldb * 2;
    const unsigned ldsw = (unsigned)wid * 1024u;
    const int aoff = lds_byte(wr * 64 + fr, fq * 8), boff = lds_byte(wc * 32 + fr, fq * 8);
#define PG8_SA(b, h) (((b) * 2 + (h)) * HTB)
#define PG8_SB(b, h) ((4 + (b) * 2 + (h)) * HTB)
#define PG8_STAGE(bufoff, gbase, voff) do { _Pragma("unroll") for (int _i = 0; _i < 2; ++_i) \
        __builtin_amdgcn_global_load_lds((const unsigned*)((const char*)(gbase) + (voff)[_i]), (LAS unsigned*)(lds + (bufoff) + ldsw + _i * 8192), 16, 0, 0); } while (0)
#define PG8_LDA(dst, b, h) do { _Pragma("unroll") for (int m = 0; m < 4; ++m) _Pragma("unroll") for (int k = 0; k < 2; ++k) dst[m][k] = *(const LAS bf16x8*)(lds + PG8_SA(b, h) + aoff + m * 2048 + k * 1024); } while (0)
#define PG8_LDB(dst, b, h) do { _Pragma("unroll") for (int n = 0; n < 2; ++n) _Pragma("unroll") for (int k = 0; k < 2; ++k) dst[n][k] = *(const LAS bf16x8*)(lds + PG8_SB(b, h) + boff + n * 2048 + k * 1024); } while (0)
#define PG8_MMA(ai, bj, At, Bt) do { __builtin_amdgcn_s_setprio(1); \
        if (SWAP) { _Pragma("unroll") for (int m = 0; m < 4; ++m) _Pragma("unroll") for (int n = 0; n < 2; ++n) _Pragma("unroll") for (int k = 0; k < 2; ++k) \
            acc[ai][bj][m][n] = __builtin_amdgcn_mfma_f32_16x16x32_bf16(At[m][k], Bt[n][k], acc[ai][bj][m][n], 0, 0, 0); } \
        else { _Pragma("unroll") for (int m = 0; m < 4; ++m) _Pragma("unroll") for (int n = 0; n < 2; ++n) _Pragma("unroll") for (int k = 0; k < 2; ++k) \
            acc[ai][bj][m][n] = __builtin_amdgcn_mfma_f32_16x16x32_bf16(Bt[n][k], At[m][k], acc[ai][bj][m][n], 0, 0, 0); } \
        __builtin_amdgcn_s_setprio(0); } while (0)
#define PG8_WAIT_V(n) asm volatile("s_waitcnt vmcnt(" #n ")" ::: "memory")
#define PG8_WAIT_L(n) asm volatile("s_waitcnt lgkmcnt(" #n ")" ::: "memory")
#define PG8_BAR __builtin_amdgcn_s_barrier()
#define PG8_SCHED __builtin_amdgcn_sched_barrier(0)
    Unit cur, nxt; int ui = 0;
    if (!next_unit(g, G, 0, cur)) return;
    Acc acc;
#pragma unroll
    for (int a = 0; a < 2; ++a)
#pragma unroll
        for (int b = 0; b < 2; ++b)
#pragma unroll
            for (int m = 0; m < 4; ++m)
#pragma unroll
                for (int n = 0; n < 2; ++n) acc[a][b][m][n] = (f32x4){0.f, 0.f, 0.f, 0.f};
    bf16x8 At[4][2], B0[2][2], B1[2][2];
    const size_t tstepA = (size_t)BM * g.lda * 2, tstepB = (size_t)BM * g.ldb * 2;
    const char* cA = (const char*)g.A + (size_t)cur.pm * tstepA; const char* cB = (const char*)g.Bt + (size_t)cur.pn * tstepB;
    PG8_STAGE(PG8_SB(0, 0), cB, voffB); PG8_STAGE(PG8_SA(0, 0), cA, voffA); PG8_STAGE(PG8_SB(0, 1), cB + hstepB, voffB); PG8_STAGE(PG8_SA(0, 1), cA + hstepA, voffA);
    if (wr == 1) PG8_BAR;
    PG8_WAIT_V(4); PG8_BAR;
    PG8_STAGE(PG8_SB(1, 0), cB + kstep, voffB); PG8_STAGE(PG8_SA(1, 0), cA + kstep, voffA); PG8_STAGE(PG8_SB(1, 1), cB + hstepB + kstep, voffB);
    PG8_WAIT_V(6); PG8_BAR;
    for (;;) {
        const bool has_next = next_unit(g, G, ui + 1, nxt);
        const char* nA = has_next ? (const char*)g.A + (size_t)nxt.pm * tstepA : cA; const char* nB = has_next ? (const char*)g.Bt + (size_t)nxt.pn * tstepB : cB;
#pragma unroll 1
        for (int t = 0; t < nt; t += 2) {
            const bool last = (t == nt - 2);
            const char* a1 = cA + (size_t)(t + 1) * kstep;
            const char* a2 = last ? nA : cA + (size_t)(t + 2) * kstep; const char* b2 = last ? nB : cB + (size_t)(t + 2) * kstep;
            const char* a3 = a2 + kstep; const char* b3 = b2 + kstep;
            PG8_LDB(B0, 0, 0); PG8_SCHED; PG8_LDA(At, 0, 0); PG8_STAGE(PG8_SA(1, 1), a1 + hstepA, voffA);
            PG8_WAIT_L(8); PG8_BAR; PG8_WAIT_L(0); PG8_MMA(0, 0, At, B0); PG8_BAR; PG8_SCHED;
            PG8_LDB(B1, 0, 1); PG8_STAGE(PG8_SB(0, 0), b2, voffB);
            PG8_BAR; PG8_WAIT_L(0); PG8_MMA(0, 1, At, B1); PG8_BAR;
            PG8_LDA(At, 0, 1); PG8_STAGE(PG8_SA(0, 0), a2, voffA);
            PG8_BAR; PG8_WAIT_L(0); PG8_MMA(1, 0, At, B0); PG8_BAR; PG8_SCHED;
            PG8_STAGE(PG8_SB(0, 1), b2 + hstepB, voffB);
            PG8_WAIT_V(6); PG8_BAR; PG8_MMA(1, 1, At, B1); PG8_BAR;
            PG8_LDB(B0, 1, 0); PG8_SCHED; PG8_LDA(At, 1, 0); PG8_STAGE(PG8_SA(0, 1), a2 + hstepA, voffA);
            PG8_WAIT_L(8); PG8_BAR; PG8_WAIT_L(0); PG8_MMA(0, 0, At, B0); PG8_BAR; PG8_SCHED;
            PG8_LDB(B1, 1, 1); PG8_STAGE(PG8_SB(1, 0), b3, voffB);
            PG8_BAR; PG8_WAIT_L(0); PG8_MMA(0, 1, At, B1); PG8_BAR;
            PG8_LDA(At, 1, 1); PG8_STAGE(PG8_SA(1, 0), a3, voffA);
            PG8_BAR; PG8_WAIT_L(0); PG8_MMA(1, 0, At, B0); PG8_BAR; PG8_SCHED;
            PG8_STAGE(PG8_SB(1, 1), b3 + hstepB, voffB);
            PG8_WAIT_V(6); PG8_BAR; PG8_MMA(1, 1, At, B1); PG8_BAR;
        }
        { Job ge; jobfn(ge); epilogue<SWAP>(ge, acc, cur, wr, wc, fr, fq); }
        if (!has_next) break;
#pragma unroll
        for (int a = 0; a < 2; ++a)
#pragma unroll
            for (int b = 0; b < 2; ++b)
#pragma unroll
                for (int m = 0; m < 4; ++m)
#pragma unroll
                    for (int n = 0; n < 2; ++n) acc[a][b][m][n] = (f32x4){0.f, 0.f, 0.f, 0.f};
        cur = nxt; cA = nA; cB = nB; ++ui;
    }
    PG8_WAIT_V(0);
    if (wr == 0) PG8_BAR;
    PG8_BAR;
#undef PG8_SA
#undef PG8_SB
#undef PG8_STAGE
#undef PG8_LDA
#undef PG8_LDB
#undef PG8_MMA
#undef PG8_WAIT_V
#undef PG8_WAIT_L
#undef PG8_BAR
#undef PG8_SCHED
}
}

#define XB_TMO      128
#define XB_XCNT(j)  (256  + 64 * (j))
#define XB_XSUB(j)  (1280 + 64 * (j))
#define XB_XGEN(j)  (2304 + 64 * (j))
#define XB_TOP      3328
#define XB_TOPGEN   3392
#define XCD_BAR_WORDS 3456
#define XB_SPIN_CAP (1u << 20)
__device__ __forceinline__ unsigned xb_ld(unsigned* p)              { return __hip_atomic_load(p, __ATOMIC_RELAXED, __HIP_MEMORY_SCOPE_AGENT); }
__device__ __forceinline__ unsigned xb_add(unsigned* p, unsigned v) { return __hip_atomic_fetch_add(p, v, __ATOMIC_RELAXED, __HIP_MEMORY_SCOPE_AGENT); }
__device__ __forceinline__ unsigned xb_xcc_id() { return (unsigned)__builtin_amdgcn_s_getreg((3 << 11) | 20) & 0xFu; }
#define XB_SPIN(cond, bar) do { unsigned _sp = 0; while (cond) { __builtin_amdgcn_s_sleep(1); \
    if ((++_sp & 255u) == 0u) { if (xb_ld(&(bar)[XB_TMO])) break; if (_sp > XB_SPIN_CAP) { atomicAdd(&(bar)[XB_TMO], 1u); break; } } } } while (0)
struct XcdBarrier { unsigned* bar; unsigned x; volatile LAS unsigned* st; };
__device__ __forceinline__ XcdBarrier xcd_barrier_post(unsigned* bar, volatile LAS unsigned* st) {
    XcdBarrier b; b.bar = bar; b.x = xb_xcc_id(); b.st = st;
    if (threadIdx.x == 0) (void)xb_add(&bar[XB_XCNT(b.x)], 1u);
    return b;
}
__device__ __forceinline__ void xcd_barrier_complete(unsigned* bar, unsigned x, unsigned& nloc, unsigned& nx) {
    const unsigned G = gridDim.x * gridDim.y * gridDim.z;
    unsigned sum, cnt, mine, sp = 0u;
    for (;;) {
        sum = 0u; cnt = 0u; mine = 0u;
#pragma unroll
        for (unsigned j = 0; j < 16; ++j) { const unsigned c = xb_ld(&bar[XB_XCNT(j)]); sum += c; cnt += (c > 0u) ? 1u : 0u; mine = (j == x) ? c : mine; }
        if (sum == G) break;
        __builtin_amdgcn_s_sleep(1);
        if ((++sp & 255u) == 0u) { if (xb_ld(&bar[XB_TMO])) break; if (sp > XB_SPIN_CAP) { atomicAdd(&bar[XB_TMO], 1u); break; } }
    }
    nloc = mine > 0u ? mine : 1u; nx = cnt > 0u ? cnt : 1u;
}
__device__ __forceinline__ void xcd_barrier(const XcdBarrier& b, const bool leader) {
    asm volatile("s_waitcnt vmcnt(0)" ::: "memory");
    __syncthreads();
    if (leader) {
        unsigned* bar = b.bar;
        __builtin_amdgcn_s_waitcnt(0);
        unsigned nloc = b.st[0], nx = b.st[1];
        if (nloc == 0u) { xcd_barrier_complete(bar, b.x, nloc, nx); b.st[0] = nloc; b.st[1] = nx; }
        const unsigned old = xb_add(&bar[XB_XSUB(b.x)], 1u);
        const unsigned gen = old / nloc;
        if (old + 1u == (gen + 1u) * nloc) {
            __builtin_amdgcn_fence(__ATOMIC_RELEASE, "agent");
            asm volatile("s_waitcnt vmcnt(0)" ::: "memory");
            const unsigned og = xb_add(&bar[XB_TOP], 1u);
            const unsigned tg = og / nx;
            if (og + 1u == (tg + 1u) * nx) xb_add(&bar[XB_TOPGEN], 1u);
            else XB_SPIN(xb_ld(&bar[XB_TOPGEN]) == tg, bar);
            __builtin_amdgcn_fence(__ATOMIC_ACQUIRE, "agent");
            xb_add(&bar[XB_XGEN(b.x)], 1u);
            asm volatile("s_waitcnt vmcnt(0)" ::: "memory");
        } else {
            XB_SPIN(xb_ld(&bar[XB_XGEN(b.x)]) == gen, bar);
            __builtin_amdgcn_fence(__ATOMIC_ACQUIRE, "agent");
            asm volatile("s_waitcnt vmcnt(0)" ::: "memory");
        }
    }
    __syncthreads();
}

struct Frame {
    LAS unsigned char* lds; GAS unsigned char* ws; int tid, lane, wave, c, G, dry;
};
#define WSP(T_, off) ((T_*)(F.ws + (off)))

__device__ __forceinline__ void transpose_item(const float* W, int ld, int K, int srccol0, bf16_t* WT, int n0, int k0, LAS float* scr, int lane) {
    const int lr = lane >> 4, lc = (lane & 15) * 4;
#pragma unroll 8
    for (int i = 0; i < 16; ++i) { const int kk = 4 * i + lr; const f32x4 v = *(const f32x4*)(W + (size_t)(k0 + kk) * ld + srccol0 + lc);
        LAS float* d = scr + kk * 65 + lc; d[0] = v[0]; d[1] = v[1]; d[2] = v[2]; d[3] = v[3]; }
    asm volatile("s_waitcnt lgkmcnt(0)" ::: "memory");
    const int cc = lane & 7;
#pragma unroll
    for (int j = 0; j < 8; ++j) { const int n = (lane >> 3) + 8 * j; const LAS float* s = scr + (8 * cc) * 65 + n;
        u32x4 o; o.x = pk2(s[0 * 65], s[1 * 65]); o.y = pk2(s[2 * 65], s[3 * 65]); o.z = pk2(s[4 * 65], s[5 * 65]); o.w = pk2(s[6 * 65], s[7 * 65]);
        *(u32x4*)(WT + (size_t)(n0 + n) * K + k0 + 8 * cc) = o; }
    asm volatile("s_waitcnt lgkmcnt(0)" ::: "memory");
}
struct CJob { const float* src; int ld, K, N; bf16_t* dst; int map; };
__device__ __forceinline__ CJob conv_job(PRef P, const Frame& F, int job) {
    CJob j{};
    switch (job) {
        case 0: j = CJob{gp(P.ffn1_w_gu), 2 * DFF, D, 2 * DFF, WSP(bf16_t, WS_WGU), 1}; break;
        case 1: j = CJob{gp(P.ffn1_w_down), D, DFF, D, WSP(bf16_t, WS_WDN), 0}; break;
        case 2: j = CJob{gp(P.w_in), 11272, D, 11264, WSP(bf16_t, WS_WIN), 2}; break;
        case 3: case 4: case 5: case 6: j = CJob{gp(P.m_wv) + (size_t)(job - 3) * 512 * 512, 512, 512, 512, WSP(bf16_t, WS_WVT) + (size_t)(job - 3) * 512 * 512, 0}; break;
        case 7: j = CJob{gp(P.w_mem_kv), 2048, D, 2048, WSP(bf16_t, WS_WMKV), 0}; break;
        case 8: j = CJob{gp(P.w_branch_m), D, 2048, D, WSP(bf16_t, WS_WBM), 0}; break;
        case 9: j = CJob{gp(P.w_branch_a), D, D, D, WSP(bf16_t, WS_WBA), 0}; break;
        case 10: j = CJob{gp(P.w_branch_x), D, D, D, WSP(bf16_t, WS_WBX), 0}; break;
        case 11: j = CJob{gp(P.w_out), D, D, D, WSP(bf16_t, WS_WOUT), 0}; break;
        case 12: j = CJob{gp(P.ffn2_w_gu), 2 * DFF, D, 2 * DFF, WSP(bf16_t, WS_WGU), 1}; break;
        default: j = CJob{gp(P.ffn2_w_down), D, DFF, D, WSP(bf16_t, WS_WDN), 0}; break;
    }
    return j;
}
__device__ __forceinline__ void convert_jobs(PRef P, const Frame& F, int job_lo, int job_hi) {
    LAS float* scr = (LAS float*)(F.lds + F.wave * 16640);
    const int gw = F.c * 8 + F.wave, NGW = F.G * 8;
    int base = 0;
    for (int job = job_lo; job < job_hi; ++job) {
        const CJob j = conv_job(P, F, job);
        const int nblk = j.N / 64, items = (j.K / 64) * nblk;
        int it = gw - (base % NGW); if (it < 0) it += NGW;
        for (; it < items; it += NGW) {
            const int kb = it / nblk, nb = it % nblk, n0 = nb * 64;
            int sc = n0;
            if (j.map == 1) { const int tile = n0 >> 8, r = n0 & 255; sc = (r < 128) ? tile * 128 + r : DFF + tile * 128 + (r - 128); }
            else if (j.map == 2) { sc = n0 < 4096 ? n0 : n0 + 8; }
            transpose_item(j.src, j.ld, j.K, sc, j.dst, n0, kb * 64, scr, F.lane);
        }
        base += items;
    }
}
__device__ __forceinline__ void rms_row_bf16(const float* xrow, const float* g, bf16_t* orow, int lane) {
    f32x4 v[4]; float s = 0.f;
#pragma unroll
    for (int j = 0; j < 4; ++j) { v[j] = ((const f32x4*)xrow)[lane + 64 * j]; s += (v[j][0] * v[j][0] + v[j][1] * v[j][1]) + (v[j][2] * v[j][2] + v[j][3] * v[j][3]); }
    const float r = 1.0f / sqrtf(wave_sum(s) * (1.f / D) + EPS);
#pragma unroll
    for (int j = 0; j < 4; ++j) { const f32x4 gv = ((const f32x4*)g)[lane + 64 * j]; u32x2 o; o.x = pk2(v[j][0] * r * gv[0], v[j][1] * r * gv[1]); o.y = pk2(v[j][2] * r * gv[2], v[j][3] * r * gv[3]);
        ((u32x2*)orow)[lane + 64 * j] = o; }
}
__device__ __forceinline__ void rowpass_bf16(const Frame& F, const float* X, const float* g, bf16_t* O, int rows) {
    const int lane = F.lane, stride = F.G * 8;
    f32x4 gv[4];
#pragma unroll
    for (int j = 0; j < 4; ++j) gv[j] = ((const f32x4*)g)[lane + 64 * j];
    for (int r0 = F.c * 8 + F.wave; r0 < rows; r0 += 4 * stride) {
        f32x4 v[4][4];
#pragma unroll
        for (int q = 0; q < 4; ++q) { const int r = r0 + q * stride;
#pragma unroll
            for (int j = 0; j < 4; ++j) v[q][j] = (r < rows) ? ((const f32x4*)(X + (size_t)r * D))[lane + 64 * j] : (f32x4){0.f, 0.f, 0.f, 0.f}; }
#pragma unroll
        for (int q = 0; q < 4; ++q) { const int r = r0 + q * stride; float s = 0.f;
#pragma unroll
            for (int j = 0; j < 4; ++j) s += (v[q][j][0] * v[q][j][0] + v[q][j][1] * v[q][j][1]) + (v[q][j][2] * v[q][j][2] + v[q][j][3] * v[q][j][3]);
            const float rr = 1.0f / sqrtf(wave_sum(s) * (1.f / D) + EPS);
            if (r < rows) {
#pragma unroll
                for (int j = 0; j < 4; ++j) { u32x2 o; o.x = pk2(v[q][j][0] * rr * gv[j][0], v[q][j][1] * rr * gv[j][1]); o.y = pk2(v[q][j][2] * rr * gv[j][2], v[q][j][3] * rr * gv[j][3]);
                    ((u32x2*)(O + (size_t)r * D))[lane + 64 * j] = o; } } }
    }
}
__device__ __forceinline__ void at_unit(PRef P, const Frame& F, int u) {
    const int h = u >> 6, tile = u & 63, n0 = (tile >> 3) * 64, k0 = (tile & 7) * 64;
    constexpr int LS = 36;
    LAS float* sK = (LAS float*)F.lds; LAS float* sQ = sK + 64 * LS;
    const float* Wk = gp(P.m_wk) + (size_t)h * 512 * 512; const float* Wq = gp(P.m_wq) + (size_t)h * 512 * 512;
    const int tn = F.tid >> 3, tk = F.tid & 7;
    float acc[8];
#pragma unroll
    for (int i = 0; i < 8; ++i) acc[i] = 0.f;
    const int lr = F.tid >> 3, lc = (F.tid & 7) * 4;
    f32x4 pk_ = *(const f32x4*)(Wk + (size_t)(n0 + lr) * 512 + lc), pq_ = *(const f32x4*)(Wq + (size_t)(k0 + lr) * 512 + lc);
#pragma unroll 1
    for (int j0 = 0; j0 < 512; j0 += 32) {
        __syncthreads();
        *(LAS f32x4*)(sK + lr * LS + lc) = pk_;
        *(LAS f32x4*)(sQ + lr * LS + lc) = pq_;
        { const int jn = (j0 + 32 < 512) ? j0 + 32 : j0; pk_ = *(const f32x4*)(Wk + (size_t)(n0 + lr) * 512 + jn + lc); pq_ = *(const f32x4*)(Wq + (size_t)(k0 + lr) * 512 + jn + lc); }
        __syncthreads();
#pragma unroll
        for (int jj = 0; jj < 32; jj += 4) { const f32x4 a = *(const LAS f32x4*)(sK + tn * LS + jj);
#pragma unroll
            for (int i = 0; i < 8; ++i) { const f32x4 q = *(const LAS f32x4*)(sQ + (tk + 8 * i) * LS + jj); acc[i] += (a[0] * q[0] + a[1] * q[1]) + (a[2] * q[2] + a[3] * q[3]); } }
    }
    bf16_t* AT = WSP(bf16_t, WS_AT) + (size_t)h * 512 * 512;
    const float sc = 0.044194173824159216f;
#pragma unroll
    for (int i = 0; i < 8; ++i) AT[(size_t)(n0 + tn) * 512 + k0 + tk + 8 * i] = (bf16_t)(pk2(acc[i] * sc, 0.f) & 0xffffu);
    __syncthreads();
}
__device__ __forceinline__ void bias_table(PRef P, const Frame& F) {
    float* TAB = WSP(float, WS_TAB);
    for (int e = F.tid; e < 8 * 128; e += 512) { const int h = e >> 7, n = e & 127; int bk;
        if (n < 16) bk = n; else { bk = 16 + (int)(logf((float)n / 16.f) / logf(8.f) * 16.f); bk = bk < 31 ? bk : 31; }
        TAB[e] = gp(P.rel_bias)[bk * 8 + h] * LOG2E; }
}
__device__ __forceinline__ void row2_phase(PRef P, const Frame& F) {
    LAS float* gw = (LAS float*)F.lds;
    for (int e = F.tid; e < 1024 * 8; e += 512) gw[e] = gp(P.w_in)[(size_t)(e >> 3) * 11272 + 4096 + (e & 7)];
    __syncthreads();
    const float* X = gp(P.out); bf16_t* H = WSP(bf16_t, WS_H); float* GATES = WSP(float, WS_GATES);
    for (int r = F.c * 8 + F.wave; r < T; r += F.G * 8) {
        const float* xrow = X + (size_t)r * D; const int lane = F.lane;
        f32x4 v[4]; float s = 0.f;
#pragma unroll
        for (int j = 0; j < 4; ++j) { v[j] = ((const f32x4*)xrow)[lane + 64 * j]; s += (v[j][0] * v[j][0] + v[j][1] * v[j][1]) + (v[j][2] * v[j][2] + v[j][3] * v[j][3]); }
        const float rr = 1.0f / sqrtf(wave_sum(s) * (1.f / D) + EPS);
        float ga[8];
#pragma unroll
        for (int q = 0; q < 8; ++q) ga[q] = 0.f;
#pragma unroll
        for (int j = 0; j < 4; ++j) { const f32x4 gv = ((const f32x4*)gp(P.mix_norm))[lane + 64 * j];
            float hv[4];
#pragma unroll
            for (int e = 0; e < 4; ++e) hv[e] = v[j][e] * rr * gv[e];
            u32x2 o; o.x = pk2(hv[0], hv[1]); o.y = pk2(hv[2], hv[3]); ((u32x2*)(H + (size_t)r * D))[lane + 64 * j] = o;
#pragma unroll
            for (int e = 0; e < 4; ++e) { const LAS f32x4* wp = (const LAS f32x4*)(gw + (size_t)(4 * (lane + 64 * j) + e) * 8); const f32x4 w0 = wp[0], w1 = wp[1];
                ga[0] += hv[e] * w0[0]; ga[1] += hv[e] * w0[1]; ga[2] += hv[e] * w0[2]; ga[3] += hv[e] * w0[3];
                ga[4] += hv[e] * w1[0]; ga[5] += hv[e] * w1[1]; ga[6] += hv[e] * w1[2]; ga[7] += hv[e] * w1[3]; } }
#pragma unroll
        for (int q = 0; q < 8; ++q) ga[q] = wave_sum(ga[q]);
        if (lane == 0) { *(f32x4*)(GATES + (size_t)r * 8) = (f32x4){ga[0], ga[1], ga[2], ga[3]}; *(f32x4*)(GATES + (size_t)r * 8 + 4) = (f32x4){ga[4], ga[5], ga[6], ga[7]}; }
    }
    __syncthreads();
}
__device__ __forceinline__ void gscan_unit(PRef P, const Frame& F, int u) {
    const int b = u >> 2, h = u & 3;
    LAS float* bb = (LAS float*)F.lds; LAS float* aa = bb + SEQ; LAS float* pp = aa + SEQ; LAS float* mprev = pp + SEQ; LAS float* mlarr = mprev + 32;
    const float* GATES = WSP(float, WS_GATES);
    const float bi = gp(P.b_if)[h], bf = gp(P.b_if)[4 + h];
    __syncthreads();
    {
        const int t0 = F.tid * 8;
        float lf[8], ig[8];
#pragma unroll
        for (int i = 0; i < 8; ++i) { const float* gp = GATES + ((size_t)b * SEQ + t0 + i) * 8; const float ip = gp[h] + bi, fp = gp[4 + h] + bf;
            lf[i] = fminf(fp, 0.f) - log1pf(expf(-fabsf(fp))); ig[i] = ip; }
        float run = 0.f;
#pragma unroll
        for (int i = 0; i < 8; ++i) { run += lf[i]; lf[i] = run; }
        float off = run;
        off += row_shr<1>(off, 0.f); off += row_shr<2>(off, 0.f); off += row_shr<4>(off, 0.f); off += row_shr<8>(off, 0.f);
        off -= run;
        float pm = -INFINITY; float av[8];
#pragma unroll
        for (int i = 0; i < 8; ++i) { lf[i] += off; av[i] = ig[i] - lf[i]; pm = fmaxf(pm, av[i]); ig[i] = pm; }
        float pmx = pm;
        pmx = fmaxf(pmx, row_shr<1>(pmx, -INFINITY)); pmx = fmaxf(pmx, row_shr<2>(pmx, -INFINITY)); pmx = fmaxf(pmx, row_shr<4>(pmx, -INFINITY)); pmx = fmaxf(pmx, row_shr<8>(pmx, -INFINITY));
        const float pex = row_shr<1>(pmx, -INFINITY);
#pragma unroll
        for (int i = 0; i < 8; ++i) { bb[t0 + i] = lf[i]; aa[t0 + i] = av[i]; pp[t0 + i] = fmaxf(ig[i], pex); }
    }
    __syncthreads();
    if (F.tid == 0) { float m = 0.f; float* DEC = WSP(float, WS_DEC) + u * 32;
        for (int c = 0; c < 32; ++c) { mprev[c] = m; const float ML = fmaxf(m, pp[c * 128 + 127]); mlarr[c] = ML; DEC[c] = expf(m - ML); m = bb[c * 128 + 127] + ML; } }
    __syncthreads();
    float *AS = WSP(float, WS_AS), *MT = WSP(float, WS_MT), *WI = WSP(float, WS_WI), *LBv = WSP(float, WS_LB), *WSv = WSP(float, WS_WS);
    for (int t = F.tid; t < SEQ; t += 512) { const int c = t >> 7; const float mp = mprev[c], Mt = fmaxf(mp, pp[t]); const size_t o = ((size_t)b * SEQ + t) * 4 + h;
        AS[o] = aa[t]; MT[o] = Mt; WI[o] = expf(mp - Mt); LBv[o] = expf(-(bb[t] + Mt)); WSv[o] = expf(aa[t] - mlarr[c]); }
    __syncthreads();
}
__device__ __forceinline__ void conv_unit(PRef P, const Frame& F, int pair, int u) {
    const int cb = u & 15, c = (u >> 4) & 31, b = u >> 9;
    const bf16_t* XM = WSP(bf16_t, WS_A); bf16_t* XC = WSP(bf16_t, WS_C); bf16_t* XT = WSP(bf16_t, WS_D); const float* WSv = WSP(float, WS_WS);
    LAS bf16_t* tile = (LAS bf16_t*)F.lds;
    const int cg = F.tid & 7, rg = F.tid >> 3;
    const int lc = cb * 64 + cg * 8, gc = pair * 1024 + lc, hg = pair * 2 + (lc >> 9);
    float w[4][8], bs[8];
#pragma unroll
    for (int j = 0; j < 4; ++j) { const f32x4 a = *(const f32x4*)(gp(P.m_conv_w) + (size_t)j * 2048 + gc), bq = *(const f32x4*)(gp(P.m_conv_w) + (size_t)j * 2048 + gc + 4);
        w[j][0] = a[0]; w[j][1] = a[1]; w[j][2] = a[2]; w[j][3] = a[3]; w[j][4] = bq[0]; w[j][5] = bq[1]; w[j][6] = bq[2]; w[j][7] = bq[3]; }
    { const f32x4 a = *(const f32x4*)(gp(P.m_conv_b) + gc), bq = *(const f32x4*)(gp(P.m_conv_b) + gc + 4); bs[0] = a[0]; bs[1] = a[1]; bs[2] = a[2]; bs[3] = a[3]; bs[4] = bq[0]; bs[5] = bq[1]; bs[6] = bq[2]; bs[7] = bq[3]; }
    const int s0 = c * 128 + 2 * rg;
    float xin[5][8];
#pragma unroll
    for (int r = 0; r < 5; ++r) { const int sp = s0 - 3 + r;
        u32x4 v = (u32x4){0u, 0u, 0u, 0u};
        if (sp >= 0) v = *(const u32x4*)(XM + ((size_t)b * SEQ + sp) * D + lc);
        xin[r][0] = bflo(v.x); xin[r][1] = bfhi(v.x); xin[r][2] = bflo(v.y); xin[r][3] = bfhi(v.y); xin[r][4] = bflo(v.z); xin[r][5] = bfhi(v.z); xin[r][6] = bflo(v.w); xin[r][7] = bfhi(v.w); }
    __syncthreads();
#pragma unroll
    for (int r = 0; r < 2; ++r) { float o[8]; const size_t tg = (size_t)b * SEQ + s0 + r; const float wsv = WSv[tg * 4 + hg];
#pragma unroll
        for (int e = 0; e < 8; ++e) { float y = bs[e];
#pragma unroll
            for (int j = 0; j < 4; ++j) y += w[j][e] * xin[r + j][e];
            o[e] = y * sigmoidf_(y); }
        u32x4 ov; ov.x = pk2(o[0], o[1]); ov.y = pk2(o[2], o[3]); ov.z = pk2(o[4], o[5]); ov.w = pk2(o[6], o[7]);
        *(u32x4*)(XC + tg * D + lc) = ov;
#pragma unroll
        for (int e = 0; e < 8; e += 2) { const unsigned pq = pk2(o[e] * wsv, o[e + 1] * wsv); tile[(cg * 8 + e) * 136 + 2 * rg + r] = (bf16_t)(pq & 0xffffu); tile[(cg * 8 + e + 1) * 136 + 2 * rg + r] = (bf16_t)(pq >> 16); } }
    __syncthreads();
    { const int d = F.tid & 63, sgq = F.tid >> 6; const int dl = (cb * 64 + d) & 511, hz = (cb * 64) >> 9;
        bf16_t* dst = XT + ((size_t)b * 2 + hz) * 512 * SEQ;
#pragma unroll
        for (int q = 0; q < 2; ++q) { const int sg = sgq + 8 * q; *(u32x4*)(dst + ((size_t)(c * 16 + sg) * 512 + dl) * 8) = *(const LAS u32x4*)(tile + d * 136 + sg * 8); } }
}
__device__ __forceinline__ void spre_unit(PRef P, const Frame& F, int pair, int u) {
    const int c = u & 31, hz = (u >> 5) & 1, b = u >> 6, hg = pair * 2 + hz;
    const bf16_t* Q = WSP(bf16_t, WS_A); const bf16_t* XC = WSP(bf16_t, WS_C); bf16_t* S = WSP(bf16_t, WS_S);
    const float *AS = WSP(float, WS_AS), *MT = WSP(float, WS_MT); float* SDEN = WSP(float, WS_SDEN);
    constexpr int RS = 1040;
    LAS unsigned char* xt = F.lds; LAS float* las = (LAS float*)(F.lds + 128 * RS);
    const size_t t0 = (size_t)b * SEQ + c * 128;
    __syncthreads();
#pragma unroll 4
    for (int i = 0; i < 16; ++i) { const int p = F.tid + 512 * i, row = p >> 6, pc = p & 63;
        *(LAS u32x4*)(xt + row * RS + pc * 16) = *(const u32x4*)(XC + (t0 + row) * D + hz * 512 + pc * 8); }
    if (F.tid < 128) las[F.tid] = AS[(t0 + F.tid) * 4 + hg];
    const int w = F.wave, fr = F.lane & 15, fq = F.lane >> 4;
    bf16x8 qf[16];
#pragma unroll
    for (int kk = 0; kk < 16; ++kk) qf[kk] = *(const bf16x8*)(Q + ((size_t)b * 2 + hz) * 512 * SEQ + ((size_t)(4 * kk + fq) * SEQ + c * 128 + 16 * w + fr) * 8);
    const float mt = MT[(t0 + 16 * w + fr) * 4 + hg];
    __syncthreads();
    float rs = 0.f; const int tl = 16 * w + fr;
    bf16_t* Sb = S + (((size_t)b * 2 + hz) * 32 + c) * 128 * 128;
#pragma unroll
    for (int n = 0; n < 8; ++n) {
        f32x4 acc = (f32x4){0.f, 0.f, 0.f, 0.f};
        if (n <= w) {
#pragma unroll
            for (int kk = 0; kk < 16; ++kk) { const bf16x8 xf = *(const LAS bf16x8*)(xt + (16 * n + fr) * RS + (32 * kk + 8 * fq) * 2); acc = __builtin_amdgcn_mfma_f32_16x16x32_bf16(xf, qf[kk], acc, 0, 0, 0); }
        }
        float o[4];
#pragma unroll
        for (int i = 0; i < 4; ++i) { const int sl = 16 * n + 4 * fq + i; o[i] = (n <= w && sl <= tl) ? acc[i] * __expf(las[sl] - mt) : 0.f; rs += o[i]; }
        u32x2 ov; ov.x = pk2(o[0], o[1]); ov.y = pk2(o[2], o[3]); *(u32x2*)(Sb + ((2 * n + (fq >> 1)) * 128 + tl) * 8 + 4 * (fq & 1)) = ov;
    }
    rs += __shfl_xor(rs, 16); rs += __shfl_xor(rs, 32);
    if (fq == 0) SDEN[(t0 + tl) * 4 + hg] = rs;
}
constexpr int SCAN_NT = 1;
constexpr int SCAN_NE = 32 / SCAN_NT;
static_assert(SCAN_NE == SCAN_PARTS, "SCAN_PARTS must equal 32 / SCAN_NT");
template <int NT>
__device__ __forceinline__ void scan_unit(PRef P, const Frame& F, int pair, int u) {
    const int xc8 = u & 7, eb = u >> 3, b = xc8 >> 1, hz = xc8 & 1, hg = pair * 2 + hz, e0 = eb * 16 * NT;
    const bf16_t* Q = WSP(bf16_t, WS_A); const bf16_t* VT = WSP(bf16_t, WS_B); bf16_t* NUM = WSP(bf16_t, WS_C); const bf16_t* XT = WSP(bf16_t, WS_D); const bf16_t* S = WSP(bf16_t, WS_S);
    const float *WI = WSP(float, WS_WI), *DEC = WSP(float, WS_DEC) + (b * 4 + hg) * 32; float* SSQ = WSP(float, WS_SSQ); bf16_t* DENP = WSP(bf16_t, WS_DENP);
    constexpr int RS = 1040, GM = 2 * NT - 1;
    LAS unsigned char* ct = F.lds;
    LAS float* nl = (LAS float*)(F.lds + 32 * RS);
    const int w = F.wave, fr = F.lane & 15, fq = F.lane >> 4;
    __syncthreads();
    for (int e = F.tid; e < (32 * RS + 128) / 16; e += 512) *(LAS u32x4*)(ct + e * 16) = (u32x4){0u, 0u, 0u, 0u};
    f32x4 Cacc[4][NT];
#pragma unroll
    for (int m = 0; m < 4; ++m)
#pragma unroll
        for (int n = 0; n < NT; ++n) Cacc[m][n] = (f32x4){0.f, 0.f, 0.f, 0.f};
    float nst = 0.f;
    const size_t bh = (size_t)b * 2 + hz;
    __syncthreads();
    bf16x8 qf[16], sf[4], vf[NT][4], xf[4][4];
    const bf16_t* qp = Q + bh * 512 * SEQ + ((size_t)fq * SEQ + 16 * w + fr) * 8;
    const bf16_t* sp = S + (bh * 32) * 128 * 128 + ((size_t)fq * 128 + 16 * w + fr) * 8;
    const bf16_t* vp = VT + bh * 512 * SEQ + ((size_t)fq * 512 + e0 + fr) * 8;
    const bf16_t* xp = XT + bh * 512 * SEQ + ((size_t)fq * 512 + 64 * w + fr) * 8;
    const bf16_t* qn = Q + bh * 512 * SEQ + ((size_t)(2 * NT * eb + (fq & GM)) * SEQ + 16 * w + fr) * 8;
    const int wstar = (NT == 1) ? (eb >> 2) : (eb >> 1), mstar = (NT == 1) ? (eb & 3) : (eb & 1) * 2;
    const int cmul = F.dry ? 0 : 1;
#define SCAN_LDQ(c_) do { _Pragma("unroll") for (int kk = 0; kk < 16; ++kk) qf[kk] = *(const bf16x8*)(qp + ((size_t)4 * kk * SEQ + ((c_) * cmul) * 128) * 8); } while (0)
#define SCAN_LDX(c_) do { _Pragma("unroll") for (int m = 0; m < 4; ++m) _Pragma("unroll") for (int ks = 0; ks < 4; ++ks) xf[m][ks] = *(const bf16x8*)(xp + ((size_t)(((c_) * cmul) * 16 + 4 * ks) * 512 + 16 * m) * 8); } while (0)
#define SCAN_LDV(c_) do { _Pragma("unroll") for (int n = 0; n < NT; ++n) _Pragma("unroll") for (int ks = 0; ks < 4; ++ks) vf[n][ks] = *(const bf16x8*)(vp + ((size_t)(((c_) * cmul) * 16 + 4 * ks) * 512 + 16 * n) * 8); } while (0)
    constexpr bool PFQ = (NT == 1);
    if (PFQ) { SCAN_LDQ(0); SCAN_LDX(0); }
#pragma unroll 1
    for (int c = 0; c < 32; ++c) {
        const size_t t0 = (size_t)b * SEQ + c * 128, tt = t0 + 16 * w + fr;
        const float wi = WI[tt * 4 + hg], dec = DEC[c];
        if (!PFQ) SCAN_LDQ(c);
        SCAN_LDV(c);
#pragma unroll
        for (int ks = 0; ks < 4; ++ks) sf[ks] = *(const bf16x8*)(sp + (size_t)(c * cmul) * 128 * 128 + 4 * ks * 128 * 8);
        const bf16x8 qn8 = *(const bf16x8*)(qn + (size_t)(c * cmul) * 128 * 8);
        f32x4 ai[NT], ae[NT];
#pragma unroll
        for (int n = 0; n < NT; ++n) { ai[n] = (f32x4){0.f, 0.f, 0.f, 0.f}; ae[n] = ai[n]; }
#pragma unroll
        for (int kk = 0; kk < 16; ++kk)
#pragma unroll
            for (int n = 0; n < NT; ++n) { const bf16x8 cf = *(const LAS bf16x8*)(ct + (16 * n + fr) * RS + (32 * kk + 8 * fq) * 2); ae[n] = __builtin_amdgcn_mfma_f32_16x16x32_bf16(cf, qf[kk], ae[n], 0, 0, 0); }
        const int cn = (c + 1 < 32) ? c + 1 : 31;
        __builtin_amdgcn_sched_barrier(0);
        if (PFQ) SCAN_LDQ(cn);
        else SCAN_LDX(c);
        __builtin_amdgcn_sched_barrier(0);
#pragma unroll
        for (int ks = 0; ks < 4; ++ks)
#pragma unroll
            for (int n = 0; n < NT; ++n) ai[n] = __builtin_amdgcn_mfma_f32_16x16x32_bf16(vf[n][ks], sf[ks], ai[n], 0, 0, 0);
        {
            const f32x4 n0 = *(const LAS f32x4*)(nl + 8 * (fq & GM)), n1 = *(const LAS f32x4*)(nl + 8 * (fq & GM) + 4);
            float dp = 0.f;
#pragma unroll
            for (int j = 0; j < 4; ++j) { dp += __uint_as_float(((unsigned)(unsigned short)qn8[j]) << 16) * n0[j]; dp += __uint_as_float(((unsigned)(unsigned short)qn8[4 + j]) << 16) * n1[j]; }
            dp += __shfl_xor(dp, 16); if (NT == 2) dp += __shfl_xor(dp, 32);
            if (fq == 0 && !(F.dry && DRYMODE == 2)) DENP[(tt * 2 + hz) * 32 + eb] = (bf16_t)(pk2(wi * dp, 0.f) & 0xffffu);
        }
        float ss = 0.f;
#pragma unroll
        for (int n = 0; n < NT; ++n) { float o[4];
#pragma unroll
            for (int i = 0; i < 4; ++i) { o[i] = ai[n][i] + wi * ae[n][i]; ss += o[i] * o[i]; }
            u32x2 ov; ov.x = pk2(o[0], o[1]); ov.y = pk2(o[2], o[3]);
            if (!(F.dry && DRYMODE == 2)) *(u32x2*)(NUM + tt * D + hz * 512 + e0 + 16 * n + 4 * fq) = ov; }
        ss += __shfl_xor(ss, 16); ss += __shfl_xor(ss, 32);
        if (fq == 0 && !(F.dry && DRYMODE == 2)) SSQ[(tt * 2 + hz) * 32 + eb] = ss;
#pragma unroll
        for (int m = 0; m < 4; ++m)
#pragma unroll
            for (int n = 0; n < NT; ++n) { Cacc[m][n] = Cacc[m][n] * dec;
#pragma unroll
                for (int ks = 0; ks < 4; ++ks) Cacc[m][n] = __builtin_amdgcn_mfma_f32_16x16x32_bf16(xf[m][ks], vf[n][ks], Cacc[m][n], 0, 0, 0); }
        if (w == wstar) {
            float r0 = 0.f, r1 = 0.f;
#define SCAN_RS(acc_, m_) do { _Pragma("unroll") for (int ks = 0; ks < 4; ++ks) _Pragma("unroll") for (int j = 0; j < 8; ++j) acc_ += __uint_as_float(((unsigned)(unsigned short)xf[m_][ks][j]) << 16); } while (0)
            if (NT == 1) { if (mstar == 0) SCAN_RS(r0, 0); else if (mstar == 1) SCAN_RS(r0, 1); else if (mstar == 2) SCAN_RS(r0, 2); else SCAN_RS(r0, 3); }
            else { if (mstar == 0) { SCAN_RS(r0, 0); SCAN_RS(r1, 1); } else { SCAN_RS(r0, 2); SCAN_RS(r1, 3); } }
#undef SCAN_RS
            r0 += __shfl_xor(r0, 16); r0 += __shfl_xor(r0, 32);
            if (NT == 2) { r1 += __shfl_xor(r1, 16); r1 += __shfl_xor(r1, 32); }
            nst = dec * nst + ((NT == 2 && (fq & 2)) ? r1 : r0);
        }
        __builtin_amdgcn_sched_barrier(0);
        if (PFQ) SCAN_LDX(cn);
        __builtin_amdgcn_sched_barrier(0);
        __builtin_amdgcn_s_waitcnt(0xC07F);
        __builtin_amdgcn_s_barrier();
#pragma unroll
        for (int m = 0; m < 4; ++m)
#pragma unroll
            for (int n = 0; n < NT; ++n) { u32x2 cv; cv.x = pk2(Cacc[m][n][0], Cacc[m][n][1]); cv.y = pk2(Cacc[m][n][2], Cacc[m][n][3]);
                *(LAS u32x2*)(ct + (16 * n + fr) * RS + (64 * w + 16 * m + 4 * fq) * 2) = cv; }
        if (NT == 1) { if (w == wstar && fq == 0) nl[fr] = nst; }
        else { if (w == wstar && (fq & 1) == 0) nl[16 * (fq >> 1) + fr] = nst; }
        __builtin_amdgcn_s_waitcnt(0xC07F);
        __builtin_amdgcn_s_barrier();
    }
#undef SCAN_LDQ
#undef SCAN_LDX
#undef SCAN_LDV
}

template <int DQ, int NDV, bool DIFF>
__device__ __forceinline__ void attn_block(const Frame& F, const bf16_t* Qb, int ldq, const bf16_t* Kb, int ldk, const bf16_t* Vtb, int ldv, bf16_t* Ob, int ldo,
                                           int q0, int nkt, float scale2, const float* tabg, float lam, const float* gnorm) {
    constexpr int KB = DIFF ? 256 : 512, KROW = KB + 16, VROW = 136, KTILE = 64 * KROW, VTILE = NDV * VROW, STAGE = KTILE + VTILE;
    constexpr int NK = (64 * KB / 16) / 512, NV = (NDV * 8) / 512, KPR = KB / 16;
    LAS unsigned char* lds = F.lds;
    LAS float* tabL = (LAS float*)(lds + 2 * STAGE);
    const int tid = F.tid, w = F.wave, lane = F.lane, qg = w >> 1, sel = w & 1, l31 = lane & 31, hh = lane >> 5;
    const int qrow = q0 + 32 * qg + l31, qmaxw = q0 + 32 * qg + 31;
    const int qcol = DIFF ? sel * 64 : 0, voff = DIFF ? 0 : sel * 128;
    __syncthreads();
    if (DIFF && tid < 129) tabL[tid] = tid ? tabg[tid - 1] : -INFINITY;
    constexpr bool QLDS = DIFF;
    LAS unsigned char* qlds = lds + 2 * STAGE + 1024 + w * 4096;
    bf16x8 qf[DQ / 16];
#pragma unroll
    for (int s = 0; s < DQ / 16; ++s) qf[s] = *(const bf16x8*)(Qb + (size_t)qrow * ldq + qcol + 16 * s + 8 * hh);
    if (QLDS) {
#pragma unroll
        for (int s = 0; s < DQ / 16; ++s) *(LAS bf16x8*)(qlds + (s * 64 + lane) * 16) = qf[s];
    }
    f32x16 O[4];
#pragma unroll
    for (int d = 0; d < 4; ++d)
#pragma unroll
        for (int i = 0; i < 16; ++i) O[d][i] = 0.f;
    float mrun = -INFINITY, lrun = 0.f;
    u32x4 kreg[NK], vreg[NV];
    unsigned koff[NK], voffs[NV];
#pragma unroll
    for (int i_ = 0; i_ < NK; ++i_) { const int p_ = tid + 512 * i_, row_ = p_ / KPR, pc_ = p_ % KPR; koff[i_] = (unsigned)(row_ * ldk + pc_ * 8) * 2u; }
#pragma unroll
    for (int i_ = 0; i_ < NV; ++i_) { const int p_ = tid + 512 * i_, row_ = p_ >> 3, pc_ = p_ & 7; voffs[i_] = (unsigned)(row_ * 64 + pc_ * 8) * 2u; }
    const int attmul = F.dry ? 0 : 1;
#define ATT_GLOAD(kt) do { const char* kb__ = (const char*)(Kb + (size_t)((kt) * attmul) * 64 * ldk); const char* vb__ = (const char*)(Vtb + (size_t)((kt) * attmul) * (NDV * 64)); \
        _Pragma("unroll") for (int i_ = 0; i_ < NK; ++i_) kreg[i_] = *(const __attribute__((address_space(1))) u32x4*)(const __attribute__((address_space(1))) char*)(kb__ + koff[i_]); \
        _Pragma("unroll") for (int i_ = 0; i_ < NV; ++i_) vreg[i_] = *(const __attribute__((address_space(1))) u32x4*)(const __attribute__((address_space(1))) char*)(vb__ + voffs[i_]); } while (0)
#define ATT_LSTORE(buf) do { LAS unsigned char* kb_ = lds + (buf) * STAGE; LAS unsigned char* vb_ = kb_ + KTILE; \
        _Pragma("unroll") for (int i_ = 0; i_ < NK; ++i_) { const int p_ = tid + 512 * i_, row_ = p_ / KPR, pc_ = p_ % KPR; *(LAS u32x4*)(kb_ + row_ * KROW + pc_ * 16) = kreg[i_]; } \
        _Pragma("unroll") for (int i_ = 0; i_ < NV; ++i_) { const int p_ = tid + 512 * i_, row_ = p_ >> 3, pc_ = p_ & 7; \
            *(LAS u32x2*)(vb_ + row_ * VROW + pc_ * 16) = (u32x2){vreg[i_].x, vreg[i_].y}; *(LAS u32x2*)(vb_ + row_ * VROW + pc_ * 16 + 8) = (u32x2){vreg[i_].z, vreg[i_].w}; } } while (0)
    constexpr bool PF = DIFF;
    if (PF) { ATT_GLOAD(0); ATT_LSTORE(0); }
    __syncthreads();
    const float c31 = DIFF ? tabL[128] : 0.f;
#pragma unroll 1
    for (int kt = 0; kt < nkt; ++kt) {
        const int buf = PF ? (kt & 1) : 0, k0 = kt * 64;
        if (PF) { if (kt + 1 < nkt) ATT_GLOAD(kt + 1); }
        else { ATT_GLOAD(kt); ATT_LSTORE(0); __syncthreads(); }
        if (!DIFF || k0 <= qmaxw) {
            const LAS unsigned char* Kt = lds + buf * STAGE; const LAS unsigned char* Vt = Kt + KTILE;
            f32x16 sacc[2];
#define ATT_QK(sub_) do { _Pragma("unroll") for (int i = 0; i < 16; ++i) sacc[sub_][i] = 0.f; \
                _Pragma("unroll") for (int s = 0; s < DQ / 16; ++s) { const bf16x8 kf = *(const LAS bf16x8*)(Kt + (32 * (sub_) + l31) * KROW + (qcol + 16 * s + 8 * hh) * 2); const bf16x8 qv = QLDS ? *(const LAS bf16x8*)(qlds + (s * 64 + lane) * 16) : qf[s]; sacc[sub_] = __builtin_amdgcn_mfma_f32_32x32x16_bf16(kf, qv, sacc[sub_], 0, 0, 0); } } while (0)
            constexpr bool QK2 = false;
            if (QK2) { ATT_QK(0); ATT_QK(1); }
#pragma unroll
            for (int sub = 0; sub < 2; ++sub) {
                const int ksub0 = k0 + 32 * sub;
                if (!QK2) { if (sub == 0) ATT_QK(0); else ATT_QK(1); }
                bf16x8 vfr[4][2];
#define ATT_VLD(d_) do { _Pragma("unroll") for (int s = 0; s < 2; ++s) { const LAS unsigned char* vp = Vt + (voff + 32 * (d_) + l31) * VROW + (32 * sub + 16 * s + 4 * hh) * 2; \
                        const bf16x4 lo = *(const LAS bf16x4*)vp, hi = *(const LAS bf16x4*)(vp + 16); vfr[d_][s] = __builtin_shufflevector(lo, hi, 0, 1, 2, 3, 4, 5, 6, 7); } } while (0)
                ATT_VLD(0);
                float sv[16]; float tmax;
                const bool nearp = DIFF && ((q0 + 32 * qg) - (ksub0 + 31) < 113);
                if (nearp) {
#pragma unroll
                    for (int i = 0; i < 16; ++i) { const int key = ksub0 + (i & 3) + 8 * (i >> 2) + 4 * hh; int idx = qrow - key + 1; idx = idx < 0 ? 0 : (idx > 128 ? 128 : idx);
                        sv[i] = sacc[sub][i] * scale2 + tabL[idx]; }
                    tmax = sv[0];
#pragma unroll
                    for (int i = 1; i < 16; ++i) tmax = fmaxf(tmax, sv[i]);
                } else {
                    tmax = sacc[sub][0];
#pragma unroll
                    for (int i = 1; i < 16; ++i) tmax = fmaxf(tmax, sacc[sub][i]);
                    tmax = tmax * scale2 + c31;
                }
                tmax = fmaxf(tmax, __shfl_xor(tmax, 32));
                const float mnew = fmaxf(mrun, tmax);
                if (__any(tmax > mrun + 8.0f)) {
                    const float alpha = __builtin_amdgcn_exp2f(mrun - mnew);
#pragma unroll
                    for (int d = 0; d < 4; ++d)
#pragma unroll
                        for (int i = 0; i < 16; ++i) O[d][i] *= alpha;
                    lrun *= alpha; mrun = mnew;
                }
                float ps = 0.f; float pv[16];
                if (nearp) {
#pragma unroll
                    for (int i = 0; i < 16; ++i) { pv[i] = __builtin_amdgcn_exp2f(sv[i] - mrun); ps += pv[i]; }
                } else { const float cm = c31 - mrun;
#pragma unroll
                    for (int i = 0; i < 16; ++i) { pv[i] = __builtin_amdgcn_exp2f(sacc[sub][i] * scale2 + cm); ps += pv[i]; }
                }
                lrun += ps;
                bf16x8 pf[2];
#pragma unroll
                for (int s = 0; s < 2; ++s) { u32x4 pk; pk.x = pk2(pv[8 * s], pv[8 * s + 1]); pk.y = pk2(pv[8 * s + 2], pv[8 * s + 3]); pk.z = pk2(pv[8 * s + 4], pv[8 * s + 5]); pk.w = pk2(pv[8 * s + 6], pv[8 * s + 7]); pf[s] = __builtin_bit_cast(bf16x8, pk); }
                ATT_VLD(1); ATT_VLD(2); ATT_VLD(3);
#pragma unroll
                for (int d = 0; d < 4; ++d)
#pragma unroll
                    for (int s = 0; s < 2; ++s) O[d] = __builtin_amdgcn_mfma_f32_32x32x16_bf16(vfr[d][s], pf[s], O[d], 0, 0, 0);
                __builtin_amdgcn_sched_barrier(0);
            }
#undef ATT_VLD
        }
        if (PF) { if (kt + 1 < nkt) ATT_LSTORE(buf ^ 1); }
        __syncthreads();
    }
#undef ATT_GLOAD
#undef ATT_QK
#undef ATT_LSTORE
    lrun += __shfl_xor(lrun, 32);
    const float inv = 1.0f / lrun;
    if (F.dry) { __syncthreads(); return; }
    int q0e = q0; asm volatile("" : "+s"(q0e));
    const int qrow_e = q0e + 32 * qg + l31;
    if (DIFF) {
        LAS float* X = (LAS float*)lds;
        if (sel == 1) {
#pragma unroll
            for (int d = 0; d < 4; ++d)
#pragma unroll
                for (int i = 0; i < 16; ++i) X[(qg * 64 + d * 16 + i) * 64 + lane] = O[d][i] * inv;
        }
        __syncthreads();
        if (sel == 0) {
            const float lamv = *(const LAS float*)(lds + LDS_BAR - 16);
            float ss = 0.f;
#pragma unroll
            for (int d = 0; d < 4; ++d)
#pragma unroll
                for (int i = 0; i < 16; ++i) { const float v = O[d][i] * inv - lamv * X[(qg * 64 + d * 16 + i) * 64 + lane]; O[d][i] = v; ss += v * v; }
            ss += __shfl_xor(ss, 32);
            const float rn = (1.0f / sqrtf(ss * (1.f / 128.f) + EPS)) * 0.8f;
#pragma unroll
            for (int d = 0; d < 4; ++d)
#pragma unroll
                for (int g = 0; g < 4; ++g) { const int dv = 32 * d + 8 * g + 4 * hh; const f32x4 gn = *(const f32x4*)(gnorm + dv);
                    u32x2 ov; ov.x = pk2(O[d][4 * g] * rn * gn[0], O[d][4 * g + 1] * rn * gn[1]); ov.y = pk2(O[d][4 * g + 2] * rn * gn[2], O[d][4 * g + 3] * rn * gn[3]);
                    *(u32x2*)(Ob + (size_t)qrow_e * ldo + dv) = ov; }
        }
    } else {
#pragma unroll
        for (int d = 0; d < 4; ++d)
#pragma unroll
            for (int g = 0; g < 4; ++g) { const int dv = voff + 32 * d + 8 * g + 4 * hh;
                u32x2 ov; ov.x = pk2(O[d][4 * g] * inv, O[d][4 * g + 1] * inv); ov.y = pk2(O[d][4 * g + 2] * inv, O[d][4 * g + 3] * inv);
                *(u32x2*)(Ob + (size_t)qrow_e * ldo + dv) = ov; }
    }
}

enum Phase { PH_PRO = 0, PH_GU1, PH_DN1, PH_ROW2,
             PH_XM0, PH_CONV0  , PH_QPROJ0, PH_SPRE0, PH_SCAN0, PH_O0, PH_BM0  ,
             PH_CONV1, PH_QPROJ1, PH_SPRE1, PH_SCAN1, PH_O1, PH_BM1,
             PH_QKV, PH_ATT, PH_BAX, PH_WOUT, PH_ROW3, PH_GU2, PH_DN2, PH_FINAL, PH_COUNT };

__device__ __forceinline__ bool get_job(PRef P, const Frame& F, int ph, int j, pg8::Job& g) {
    using namespace pg8;
    bf16_t* H = WSP(bf16_t, WS_H); bf16_t* MG = WSP(bf16_t, WS_MERGED);
    bf16_t *SA = WSP(bf16_t, WS_A), *SB = WSP(bf16_t, WS_B), *SC = WSP(bf16_t, WS_C), *SD = WSP(bf16_t, WS_D);
    const bf16_t* WIN = WSP(bf16_t, WS_WIN);
    g = Job{}; g.lda = D; g.ldb = D; g.K = D; g.nM = 64; g.nN = 4; g.c = F.c; g.kind = E_NONE;
    int rot = 0;
    const int pair = (ph >= PH_CONV1 && ph <= PH_BM1) ? 1 : 0;
    switch (ph) {
    case PH_GU1: case PH_GU2:
        if (j == 0) { g.A = H; g.Bt = WSP(bf16_t, WS_WGU); g.nN = 22; g.kind = E_SWIGLU; g.o0 = WSP(bf16_t, WS_ACT); }
        else if (ph == PH_GU1 && j == 1) { g.A = WSP(bf16_t, WS_MEMN); g.Bt = WSP(bf16_t, WS_WMKV); g.nM = 4; g.kind = E_BF16; g.o0 = WSP(bf16_t, WS_KX); g.i0 = D; rot = 128; }
        else if (ph == PH_GU1 && j == 2) { g.A = WSP(bf16_t, WS_MEMN); g.Bt = WSP(bf16_t, WS_WMKV) + (size_t)1024 * D; g.nM = 4; g.kind = E_TRANS; g.o0 = WSP(bf16_t, WS_VXT); g.i0 = 8; g.i1 = 8; g.i2 = 6; g.s0 = 4 * 256 * 256; g.s1 = 256 * 256; rot = 112; }
        break;
    case PH_DN1: case PH_DN2:
        if (j == 0) { g.A = WSP(bf16_t, WS_ACT); g.lda = DFF; g.Bt = WSP(bf16_t, WS_WDN); g.ldb = DFF; g.K = DFF; g.kind = E_RESID; g.o0 = gp(P.out); g.p1 = (ph == PH_DN1) ? gp(P.x) : gp(P.out); g.f0 = 0.5f; }
        break;
    case PH_XM0:
        if (j == 0) { g.A = H; g.Bt = WIN; g.kind = E_BF16; g.o0 = SA; g.i0 = D; }
        break;
    case PH_CONV0: case PH_CONV1:
        if (j < 2) { g.A = SA + j * 512; g.Bt = WSP(bf16_t, WS_WVT) + (size_t)(pair * 2 + j) * 512 * 512; g.ldb = 512; g.K = 512; g.nN = 2; g.kind = E_TRANS; g.o0 = SB + (size_t)j * 512 * SEQ;
            g.i0 = 12; g.i1 = 9; g.i2 = 3; g.s0 = (long)2 * 512 * SEQ; g.s1 = 0; rot = j * 128; }
        break;
    case PH_QPROJ0: case PH_QPROJ1:
        if (j < 2) { g.A = SC + j * 512; g.Bt = WSP(bf16_t, WS_AT) + (size_t)(pair * 2 + j) * 512 * 512; g.ldb = 512; g.K = 512; g.nN = 2; g.kind = E_QPANEL; g.o0 = SA + (size_t)j * 512 * SEQ; g.s0 = (long)2 * 512 * SEQ; rot = j * 128; }
        break;
    case PH_O0: case PH_O1:
        if (j == 0) { g.A = H; g.Bt = WIN + (size_t)(2048 + pair * 1024) * D; g.kind = E_OGATE; g.o0 = SC; g.p1 = WSP(float, WS_SDEN); g.p2 = WSP(float, WS_LB); g.p3 = WSP(float, WS_SSQ); g.p4 = gp(P.m_head_norm); g.i0 = pair; }
        break;
    case PH_BM0:
        if (j == 0) { g.A = SC; g.Bt = WSP(bf16_t, WS_WBM); g.ldb = 2048; g.kind = E_MERGE0; g.o0 = MG; }
        else if (j == 1) { g.A = H; g.Bt = WIN + (size_t)1024 * D; g.kind = E_BF16; g.o0 = SA; g.i0 = D; }
        break;
    case PH_BM1:
        if (j == 0) { g.A = H; g.Bt = WIN + (size_t)8192 * D; g.kind = E_SIGB; g.o0 = SD; g.i0 = D; g.p1 = gp(P.b_gate); }
        else if (j == 1) { g.A = SC; g.Bt = WSP(bf16_t, WS_WBM) + 1024; g.ldb = 2048; g.kind = E_MERGE1; g.o0 = MG; g.p1 = SD; }
        break;
    case PH_QKV:
        if (j == 0) { g.A = H; g.Bt = WIN + (size_t)4096 * D; g.nN = 8; g.kind = E_BF16; g.o0 = SA; g.i0 = D; g.i1 = 4; g.s0 = (long)((WS_B - WS_A) / 2); }
        else if (j == 1) { g.A = H; g.Bt = WIN + (size_t)6144 * D; g.kind = E_TRANS; g.o0 = SC; g.i0 = 12; g.i1 = 7; g.i2 = 6; g.s0 = (long)8 * 128 * SEQ; g.s1 = (long)128 * SEQ; }
        else if (j == 2) { g.A = H; g.Bt = WIN + (size_t)7168 * D; g.kind = E_BF16; g.o0 = SD; g.i0 = D; }
        break;
    case PH_BAX:
        if (j == 0) { g.A = H; g.Bt = WIN + (size_t)(8192 + 1024) * D; g.kind = E_SIGB; g.o0 = SB; g.i0 = D; g.p1 = gp(P.b_gate) + 1024; }
        else if (j == 1) { g.A = SA; g.Bt = WSP(bf16_t, WS_WBA); g.kind = E_MERGE2; g.o0 = MG; g.p1 = SB; }
        else if (j == 2) { g.A = H; g.Bt = WIN + (size_t)(8192 + 2048) * D; g.kind = E_SIGB; g.o0 = SC; g.i0 = D; g.p1 = gp(P.b_gate) + 2048; }
        else if (j == 3) { g.A = SD; g.Bt = WSP(bf16_t, WS_WBX); g.kind = E_MERGE2; g.o0 = MG; g.p1 = SC; }
        break;
    case PH_WOUT:
        if (j == 0) { g.A = MG; g.Bt = WSP(bf16_t, WS_WOUT); g.kind = E_RESID; g.o0 = gp(P.out); g.p1 = gp(P.out); g.f0 = 1.0f; }
        break;
    default: break;
    }
    g.c = (F.c + rot) % F.G; g.dry = F.dry;
    return g.kind != E_NONE;
}

__device__ __forceinline__ void run_phase(const Frame& F0, int ph) {
    const __attribute__((address_space(4))) ParamsG* kp_ = (const __attribute__((address_space(4))) ParamsG*)__builtin_amdgcn_kernarg_segment_ptr();
    asm volatile("" : "+s"(kp_));
    PRef P = *kp_;
    Frame F = F0;
    { int w_ = F.wave, c_ = F.c; asm volatile("" : "+s"(w_)); asm volatile("" : "+s"(c_));
      int l_ = (int)__builtin_amdgcn_mbcnt_hi(~0u, __builtin_amdgcn_mbcnt_lo(~0u, 0u)); asm volatile("" : "+v"(l_));
      F.tid = w_ * 64 + l_; F.lane = l_; F.wave = w_; F.c = c_;
      GAS unsigned char* ws_ = F.ws; asm volatile("" : "+s"(ws_)); F.ws = ws_; int g_ = F.G; asm volatile("" : "+s"(g_)); F.G = g_; }
    const int pair = (ph >= PH_CONV1 && ph <= PH_BM1) ? 1 : 0;
    switch (ph) {
    case PH_PRO: {
        convert_jobs(P, F, 0, 12);
        rowpass_bf16(F, gp(P.x), gp(P.ffn1_norm), WSP(bf16_t, WS_H), T);
        rowpass_bf16(F, gp(P.mem), gp(P.mem_norm), WSP(bf16_t, WS_MEMN), NB * MEML);
        if (F.c == F.G - 1) bias_table(P, F);
        __syncthreads();
        for (int u = F.c; u < 256; u += F.G) at_unit(P, F, u);
    } break;
    case PH_ROW2: row2_phase(P, F); break;
    case PH_GU2: if (F.c >= F.G / 2) { Frame F2 = F; F2.c = F.c - F.G / 2; F2.G = F.G - F.G / 2; convert_jobs(P, F2, 13, 14); } break;
    case PH_XM0: for (int u = F.c; u < 16; u += F.G) gscan_unit(P, F, u); break;
    case PH_CONV0: case PH_CONV1: for (int u = F.c; u < 2048; u += F.G) conv_unit(P, F, pair, u); break;
    case PH_SPRE0: case PH_SPRE1: for (int u = F.c; u < 256; u += F.G) spre_unit(P, F, pair, u); break;
    case PH_SCAN0: case PH_SCAN1: for (int u = F.c; u < 8 * SCAN_NE; u += F.G) scan_unit<SCAN_NT>(P, F, pair, u); break;
    case PH_ATT: {
        float lam;
        { float s1 = 0.f, s2 = 0.f; for (int i = 0; i < 64; ++i) { s1 += gp(P.a_lam_q1)[i] * gp(P.a_lam_k1)[i]; s2 += gp(P.a_lam_q2)[i] * gp(P.a_lam_k2)[i]; } lam = expf(s1) - expf(s2) + 0.2f; }
        if (F.tid == 0) *(LAS float*)(F.lds + LDS_BAR - 16) = lam;
        lam = 0.f;
        bf16_t *SA = WSP(bf16_t, WS_A), *SB = WSP(bf16_t, WS_B), *SC = WSP(bf16_t, WS_C), *SD = WSP(bf16_t, WS_D);
#pragma unroll 1
        for (int u = F.c; u < 512; u += F.G) {
            const int xcd = u & 7, idx = u >> 3, bh = xcd * 4 + (idx >> 4), j = idx & 15, b = bh >> 3, h = bh & 7;
            const bf16_t* Qb = SA + (size_t)b * SEQ * D + h * 128; const bf16_t* Kb = SB + (size_t)b * SEQ * D + h * 128; const bf16_t* Vtb = SC + (size_t)(b * 8 + h) * 128 * SEQ;
#pragma unroll 1
            for (int side = 0; side < 2; ++side) { const int qb = side ? 31 - j : j;
                attn_block<64, 128, true>(F, Qb, D, Kb, D, Vtb, SEQ, (bf16_t*)Qb, D, qb * 128, 2 * qb + 2, 0.125f * LOG2E, WSP(float, WS_TAB) + h * 128, lam, gp(P.a_head_norm) + h * 128); }
        }
#pragma unroll 1
        for (int u = F.c; u < 512; u += F.G) {
            const int xcd = u & 7, idx = u >> 3, bh = xcd * 2 + (idx >> 5), qb = idx & 31, b = bh >> 2, h = bh & 3;
            const bf16_t* Qb = SD + (size_t)b * SEQ * D + h * 256; const bf16_t* Kb = WSP(bf16_t, WS_KX) + (size_t)b * MEML * D + h * 256; const bf16_t* Vtb = WSP(bf16_t, WS_VXT) + (size_t)(b * 4 + h) * 256 * 256;
            attn_block<256, 256, false>(F, Qb, D, Kb, D, Vtb, 256, (bf16_t*)Qb, D, qb * 128, 4, 0.0625f * LOG2E, nullptr, 0.f, nullptr);
        }
    } break;
    case PH_ROW3: rowpass_bf16(F, gp(P.out), gp(P.ffn2_norm), WSP(bf16_t, WS_H), T); break;
    case PH_FINAL: {
        const int lane = F.lane, stride = F.G * 8; float* OUT = gp(P.out);
        f32x4 gv[4];
#pragma unroll
        for (int j = 0; j < 4; ++j) gv[j] = ((const f32x4*)gp(P.final_norm))[lane + 64 * j];
        for (int r0 = F.c * 8 + F.wave; r0 < T; r0 += 4 * stride) {
            f32x4 v[4][4];
#pragma unroll
            for (int q = 0; q < 4; ++q) { const int r = r0 + q * stride;
#pragma unroll
                for (int j = 0; j < 4; ++j) v[q][j] = (r < T) ? ((const f32x4*)(OUT + (size_t)r * D))[lane + 64 * j] : (f32x4){0.f, 0.f, 0.f, 0.f}; }
#pragma unroll
            for (int q = 0; q < 4; ++q) { const int r = r0 + q * stride; float s = 0.f;
#pragma unroll
                for (int j = 0; j < 4; ++j) s += (v[q][j][0] * v[q][j][0] + v[q][j][1] * v[q][j][1]) + (v[q][j][2] * v[q][j][2] + v[q][j][3] * v[q][j][3]);
                const float rr = 1.0f / sqrtf(wave_sum(s) * (1.f / D) + EPS);
                if (r < T && !F.dry) {
#pragma unroll
                    for (int j = 0; j < 4; ++j) ((f32x4*)(OUT + (size_t)r * D))[lane + 64 * j] = v[q][j] * rr * gv[j]; } }
        }
    } break;
    default: break;
    }
    __syncthreads();
#pragma unroll 1
    for (int j = 0; j < 4; ++j) { pg8::Job g; if (!get_job(P, F, ph, j, g)) break;
        auto jobfn = [&](pg8::Job& ge) { int ph_ = ph, j_ = j; asm volatile("" : "+s"(ph_), "+s"(j_)); (void)get_job(P, F, ph_, j_, ge); };
        if (g.kind == pg8::E_TRANS) pg8::gemm_run<true>(F.lds, g, F.G, F.tid, jobfn); else pg8::gemm_run<false>(F.lds, g, F.G, F.tid, jobfn); }
    if (ph == PH_WOUT) convert_jobs(P, F, 12, 13);
}

extern "C" __global__ void __launch_bounds__(512, 2) mega_fwd(Params P) {
    extern __shared__ __attribute__((aligned(16))) unsigned char smem[];
    Frame F; F.lds = (LAS unsigned char*)smem; F.ws = (GAS unsigned char*)P.ws; F.tid = threadIdx.x; F.lane = threadIdx.x & 63; F.wave = __builtin_amdgcn_readfirstlane(threadIdx.x >> 6);
    F.c = blockIdx.x; F.G = gridDim.x; F.dry = 0;
#if N_LAUNCH_MODE == 1
    volatile LAS unsigned* st = (volatile LAS unsigned*)(F.lds + LDS_BAR);
    if (threadIdx.x == 0) { st[0] = 0u; st[1] = 0u; }
    __syncthreads();
    XcdBarrier bar = xcd_barrier_post((unsigned*)((GAS unsigned char*)P.ws + WS_CTL), st);
#endif
#ifdef ONLY_PHASE
    run_phase(F, ONLY_PHASE);
#endif
    int rep = 0;
    for (int ph = P.ph_lo; ph < P.ph_hi;) {
        const int extra = (int)((REP_MASK >> ph) & 1ull) * REP_N;
        F.dry = (rep < extra) ? (int)((DRY_MASK >> ph) & 1ull) : 0;
#ifndef ONLY_PHASE
        run_phase(F, ph);
#endif
        if (rep < extra) ++rep; else { rep = 0; ++ph; }
#if N_LAUNCH_MODE == 1
        if (ph < P.ph_hi) { int w_ = F.wave; asm volatile("" : "+s"(w_)); int l_ = (int)__builtin_amdgcn_mbcnt_hi(~0u, __builtin_amdgcn_mbcnt_lo(~0u, 0u)); asm volatile("" : "+v"(l_)); xcd_barrier(bar, w_ == 0 && l_ == 0); }
#endif
    }
}

extern "C" void kernel_launch(void* const* d_in, const int* in_sizes, int n_in, void* d_out, int out_size, void* d_ws, size_t ws_size, hipStream_t stream) {
    static int grid = 0;
    if (grid == 0) {
        if (n_in != 32 || in_sizes[0] != T * D || out_size != T * D || ws_size < WS_END) { fprintf(stderr, "kernel_launch: unexpected shapes (n_in %d, in0 %d, out %d, ws %zu); nothing launched\n", n_in, n_in > 0 ? in_sizes[0] : -1, out_size, ws_size); grid = -1; return; }
        int dev = 0, cus = 0;
        if (hipGetDevice(&dev) != hipSuccess || hipDeviceGetAttribute(&cus, hipDeviceAttributeMultiprocessorCount, dev) != hipSuccess) { grid = -1; return; }
        if (hipFuncSetAttribute((const void*)mega_fwd, hipFuncAttributeMaxDynamicSharedMemorySize, LDS_BYTES) != hipSuccess) { fprintf(stderr, "kernel_launch: hipFuncSetAttribute failed\n"); grid = -1; return; }
        int per_cu = 0;
        if (hipOccupancyMaxActiveBlocksPerMultiprocessor(&per_cu, (const void*)mega_fwd, 512, LDS_BYTES) != hipSuccess || per_cu < 1) fprintf(stderr, "kernel_launch: occupancy query reports %d blocks per CU\n", per_cu);
        (void)hipGetLastError();
        grid = cus;
    }
    if (grid < 0) return;
    Params p{};
    const float** fp = (const float**)&p.x;
    (void)fp;
    p.x = (const float*)d_in[0]; p.mem = (const float*)d_in[1]; p.positions = (const int*)d_in[2]; p.rel_bias = (const float*)d_in[3];
    p.ffn1_norm = (const float*)d_in[4]; p.ffn1_w_gu = (const float*)d_in[5]; p.ffn1_w_down = (const float*)d_in[6]; p.mix_norm = (const float*)d_in[7]; p.mem_norm = (const float*)d_in[8];
    p.w_in = (const float*)d_in[9]; p.b_if = (const float*)d_in[10]; p.b_gate = (const float*)d_in[11]; p.m_conv_w = (const float*)d_in[12]; p.m_conv_b = (const float*)d_in[13];
    p.m_wq = (const float*)d_in[14]; p.m_wk = (const float*)d_in[15]; p.m_wv = (const float*)d_in[16]; p.m_head_norm = (const float*)d_in[17];
    p.a_lam_q1 = (const float*)d_in[18]; p.a_lam_k1 = (const float*)d_in[19]; p.a_lam_q2 = (const float*)d_in[20]; p.a_lam_k2 = (const float*)d_in[21]; p.a_head_norm = (const float*)d_in[22];
    p.w_mem_kv = (const float*)d_in[23]; p.w_branch_m = (const float*)d_in[24]; p.w_branch_a = (const float*)d_in[25]; p.w_branch_x = (const float*)d_in[26]; p.w_out = (const float*)d_in[27];
    p.ffn2_norm = (const float*)d_in[28]; p.ffn2_w_gu = (const float*)d_in[29]; p.ffn2_w_down = (const float*)d_in[30]; p.final_norm = (const float*)d_in[31];
    p.out = (float*)d_out; p.ws = (unsigned char*)d_ws;
#if N_LAUNCH_MODE == 1
    if (hipMemsetAsync((char*)d_ws + WS_CTL, 0, CTL_BYTES, stream) != hipSuccess) { fprintf(stderr, "kernel_launch: memset failed\n"); return; }
    p.ph_lo = 0; p.ph_hi = PH_COUNT;
    hipLaunchKernelGGL(mega_fwd, dim3(grid), dim3(512), LDS_BYTES, stream, p);
#else
    for (int ph = 0; ph < PH_COUNT; ++ph) { p.ph_lo = ph; p.ph_hi = ph + 1; hipLaunchKernelGGL(mega_fwd, dim3(grid), dim3(512), LDS_BYTES, stream, p); }
#endif
    const hipError_t le = hipPeekAtLastError();
    if (le != hipSuccess) fprintf(stderr, "kernel_launch: launch failed: %s\n", hipGetErrorName(le));
}
```
